# Optimizing an MI355X kernel written in HIP

```python
import jax, jax.numpy as jnp
from jax import lax
import numpy as np

D_MODEL = 1024
BATCH = 2
SEQ = 8192
DEPTH = 2

HEAD_DIM = 64
ROPE_THETA = 10000.0
Q_BLOCK = 128
NORM_EPS = 1e-6
NEG_INF = -1e30

NSA_HEADS = 8
NSA_GROUPS = 2
NSA_HPG = NSA_HEADS // NSA_GROUPS
CMP_LEN = 32
CMP_STRIDE = 16
CMP_HIDDEN = 256
SEL_LEN = 64
SEL_TOPN = 16
WINDOW = 512
FORCE_SCORE = 1e4

RET_HEADS = 4
RET_QK_DIM = 64
RET_V_DIM = 128
RET_CHUNK = 128

FOX_HEADS = 8

D_FF = 2816
N_EXPERTS = 8
TOP_K = 2
D_FF_EXPERT = 3584
N_DENSE = (DEPTH + 1) // 2
N_MOE = DEPTH // 2

NSA_Q = NSA_HEADS * HEAD_DIM
NSA_KV = NSA_GROUPS * HEAD_DIM
RET_QK = RET_HEADS * RET_QK_DIM
RET_V = RET_HEADS * RET_V_DIM
FOX_W = FOX_HEADS * HEAD_DIM
IN_SPLITS = (NSA_Q, NSA_KV, NSA_KV, NSA_KV, NSA_KV, NSA_KV, NSA_KV, 3 * NSA_HEADS,
             RET_QK, RET_QK, RET_V, RET_V,
             FOX_W, FOX_W, FOX_W, FOX_HEADS,
             3 * D_MODEL)
D_IN = sum(IN_SPLITS)

kernel_name = 'hybrid_nsa_retention_fox_moe_block'


def rms_norm(x, g):
    xf = x.astype(jnp.float32)
    y = xf * lax.rsqrt(jnp.mean(xf * xf, axis=-1, keepdims=True) + NORM_EPS)
    return (y * g.astype(jnp.float32)).astype(x.dtype)


def rope(x, pos):
    d = x.shape[-1]
    inv = ROPE_THETA ** (-jnp.arange(0, d, 2, dtype=jnp.float32) / d)
    ang = pos[:, None] * inv[None, :]
    ang = jnp.concatenate([ang, ang], axis=-1)[:, None, :]
    xf = x.astype(jnp.float32)
    x1, x2 = jnp.split(xf, 2, axis=-1)
    rot = jnp.concatenate([-x2, x1], axis=-1)
    return (xf * jnp.cos(ang) + rot * jnp.sin(ang)).astype(x.dtype)


def _masked_softmax(s, mask):
    s = jnp.where(mask, s.astype(jnp.float32), NEG_INF)
    return jnp.where(mask, jax.nn.softmax(s, axis=-1), 0.0)


def _gather_blocks(blocks, idx):
    return jax.vmap(jax.vmap(lambda bl, ix: bl[ix]))(blocks, idx)


def _compress(x, pe, w1, w2, tok_idx):
    B, _, G, dh = x.shape
    blk = x[:, tok_idx] + pe[:, None, :]
    blk = jnp.moveaxis(blk, 3, 1)
    blk = blk.reshape(B, G, tok_idx.shape[0], CMP_LEN * dh)
    return jax.nn.silu(blk @ w1) @ w2


def native_sparse_attention(q, k_cmp, v_cmp, k_sel, v_sel, k_win, v_win, gate_logits,
                            ck_pe, ck_w1, ck_w2, cv_pe, cv_w1, cv_w2):
    B, T, H, dh = q.shape
    G = NSA_GROUPS
    f32 = jnp.float32
    q, k_cmp, v_cmp, k_sel, v_sel, k_win, v_win = [a.astype(f32) for a in (q, k_cmp, v_cmp, k_sel, v_sel, k_win, v_win)]
    n_cmp = (T - CMP_LEN) // CMP_STRIDE + 1
    n_sel = T // SEL_LEN
    top_n = min(SEL_TOPN, n_sel)
    n_qb = T // Q_BLOCK
    scale = dh ** -0.5

    tok_idx = jnp.arange(n_cmp)[:, None] * CMP_STRIDE + jnp.arange(CMP_LEN)[None, :]
    kc = _compress(k_cmp, ck_pe, ck_w1, ck_w2, tok_idx)
    vc = _compress(v_cmp, cv_pe, cv_w1, cv_w2, tok_idx)
    cmp_start = jnp.arange(n_cmp) * CMP_STRIDE
    cmp_end = cmp_start + CMP_LEN - 1
    sel_start = jnp.arange(n_sel) * SEL_LEN
    overlap = ((cmp_start[:, None] < sel_start[None, :] + SEL_LEN)
               & (cmp_start[:, None] + CMP_LEN > sel_start[None, :])).astype(f32)
    sel_id = jnp.arange(n_sel)

    ks_blk = k_sel.reshape(B, n_sel, SEL_LEN, G, dh).transpose(0, 3, 1, 2, 4)
    vs_blk = v_sel.reshape(B, n_sel, SEL_LEN, G, dh).transpose(0, 3, 1, 2, 4)
    kw_pad = jnp.pad(k_win, ((0, 0), (WINDOW, 0), (0, 0), (0, 0))).transpose(0, 2, 1, 3)
    vw_pad = jnp.pad(v_win, ((0, 0), (WINDOW, 0), (0, 0), (0, 0))).transpose(0, 2, 1, 3)
    qg = q.reshape(B, T, G, NSA_HPG, dh).transpose(0, 2, 3, 1, 4)

    def block(i):
        t0 = i * Q_BLOCK
        tq = t0 + jnp.arange(Q_BLOCK)
        qb = lax.dynamic_slice_in_dim(qg, t0, Q_BLOCK, axis=3) * scale
        s = jnp.einsum('bghqd,bgnd->bghqn', qb, kc)
        p = _masked_softmax(s, cmp_end[None, :] <= tq[:, None])
        o_cmp = jnp.einsum('bghqn,bgnd->bghqd', p, vc)
        imp = jnp.einsum('bghqn,ns->bgqs', p, overlap)
        cur = (tq // SEL_LEN)[:, None]
        forced = (sel_id == 0) | (sel_id == cur) | (sel_id == cur - 1)
        score = jnp.where(forced, FORCE_SCORE, imp)
        score = jnp.where(sel_id <= cur, score, NEG_INF)
        _, idx = lax.top_k(score, top_n)
        kg = _gather_blocks(ks_blk, idx).reshape(B, G, Q_BLOCK, top_n * SEL_LEN, dh)
        vg = _gather_blocks(vs_blk, idx).reshape(B, G, Q_BLOCK, top_n * SEL_LEN, dh)
        tok = (idx[..., None] * SEL_LEN + jnp.arange(SEL_LEN)).reshape(B, G, 1, Q_BLOCK, top_n * SEL_LEN)
        s = jnp.einsum('bghqd,bgqkd->bghqk', qb, kg)
        p = _masked_softmax(s, tok <= tq[:, None])
        o_sel = jnp.einsum('bghqk,bgqkd->bghqd', p, vg)
        kw = lax.dynamic_slice_in_dim(kw_pad, t0, Q_BLOCK + WINDOW, axis=2)
        vw = lax.dynamic_slice_in_dim(vw_pad, t0, Q_BLOCK + WINDOW, axis=2)
        kpos = t0 - WINDOW + jnp.arange(Q_BLOCK + WINDOW)
        rel = tq[:, None] - kpos[None, :]
        wmask = (rel >= 0) & (rel < WINDOW) & (kpos[None, :] >= 0)
        s = jnp.einsum('bghqd,bgkd->bghqk', qb, kw)
        o_win = jnp.einsum('bghqk,bgkd->bghqd', _masked_softmax(s, wmask), vw)
        return o_cmp, o_sel, o_win

    outs = lax.map(block, jnp.arange(n_qb))
    o_cmp, o_sel, o_win = [o.transpose(1, 0, 4, 2, 3, 5).reshape(B, T, H, dh) for o in outs]
    g = jax.nn.sigmoid(gate_logits.astype(f32)).reshape(B, T, 3, H, 1)
    o = g[:, :, 0] * o_cmp + g[:, :, 1] * o_sel + g[:, :, 2] * o_win
    return o.reshape(B, T, H * dh)


def retention(q, k, v, g):
    f32 = jnp.float32
    q, k, v, g = [a.astype(f32) for a in (q, k, v, g)]
    B, T, H, dk = q.shape
    dv = v.shape[-1]
    C = RET_CHUNK
    n_c = T // C
    log_g = jnp.log(1.0 - 2.0 ** (-5.0 - jnp.arange(H, dtype=f32)))
    n = jnp.arange(C, dtype=f32)
    diff = n[:, None] - n[None, :]
    causal = diff >= 0
    decay_in = jnp.where(causal[None], jnp.exp(jnp.where(causal, diff, 0.0)[None] * log_g[:, None, None]), 0.0)
    q_decay = jnp.exp((n[None, :] + 1.0) * log_g[:, None])[None, :, :, None]
    k_decay = jnp.exp((C - 1.0 - n)[None, :] * log_g[:, None])[None, :, :, None]
    chunk_decay = jnp.exp(C * log_g)[None, :, None, None]

    def to_chunks(a):
        return a.reshape(B, n_c, C, H, a.shape[-1]).transpose(1, 0, 3, 2, 4)

    def step(state, inp):
        qc, kc, vc = inp
        inner = jnp.einsum('bhnd,bhmd->bhnm', qc, kc) * decay_in
        o = jnp.einsum('bhnm,bhme->bhne', inner, vc) + jnp.einsum('bhnd,bhde->bhne', qc * q_decay, state)
        state = state * chunk_decay + jnp.einsum('bhmd,bhme->bhde', kc * k_decay, vc)
        return state, o

    state0 = jnp.zeros((B, H, dk, dv), f32)
    _, o = lax.scan(step, state0, (to_chunks(q), to_chunks(k), to_chunks(v)))
    o = o.transpose(1, 0, 3, 2, 4).reshape(B, T, H, dv)
    mu = jnp.mean(o, axis=-1, keepdims=True)
    var = jnp.mean(jnp.square(o - mu), axis=-1, keepdims=True)
    o = (o - mu) * lax.rsqrt(var + NORM_EPS)
    return (jax.nn.silu(g) * o).reshape(B, T, H * dv)


def forgetting_attention(q, k, v, f_logit):
    f32 = jnp.float32
    B, T, H, dh = q.shape
    n_qb = T // Q_BLOCK
    scale = dh ** -0.5
    qh, kh, vh = [a.astype(f32).transpose(0, 2, 1, 3) for a in (q, k, v)]
    cum = jnp.cumsum(jax.nn.log_sigmoid(f_logit.astype(f32)), axis=1).transpose(0, 2, 1)
    kpos = jnp.arange(T)

    def block(i):
        t0 = i * Q_BLOCK
        tq = t0 + jnp.arange(Q_BLOCK)
        qb = lax.dynamic_slice_in_dim(qh, t0, Q_BLOCK, axis=2)
        cq = lax.dynamic_slice_in_dim(cum, t0, Q_BLOCK, axis=2)
        s = jnp.einsum('bhqd,bhkd->bhqk', qb, kh) * scale + (cq[..., None] - cum[:, :, None, :])
        p = _masked_softmax(s, kpos[None, :] <= tq[:, None])
        return jnp.einsum('bhqk,bhkd->bhqd', p, vh)

    o = lax.map(block, jnp.arange(n_qb))
    return o.transpose(1, 0, 3, 2, 4).reshape(B, T, H * dh)


def token_mixing(h, w_in, ck_pe, ck_w1, ck_w2, cv_pe, cv_w1, cv_w2, fox_f_bias,
                 w_read_nsa, w_read_ret, w_read_fox, w_out):
    B, T, _ = h.shape
    pos = jnp.arange(T, dtype=jnp.float32)
    points = np.cumsum(IN_SPLITS)[:-1].tolist()
    (nq, nkc, nvc, nks, nvs, nkw, nvw, ngate, rq, rk, rv, rg,
     fq, fk, fv, ff, mg) = jnp.split(h @ w_in, points, axis=-1)

    def heads(a, n_h):
        return a.reshape(B, T, n_h, -1)

    G = NSA_GROUPS
    o_nsa = native_sparse_attention(
        rope(heads(nq, NSA_HEADS), pos), rope(heads(nkc, G), pos), heads(nvc, G),
        rope(heads(nks, G), pos), heads(nvs, G), rope(heads(nkw, G), pos), heads(nvw, G), ngate,
        ck_pe, ck_w1, ck_w2, cv_pe, cv_w1, cv_w2)
    o_ret = retention(rope(heads(rq, RET_HEADS), pos),
                      rope(heads(rk, RET_HEADS), pos) * (RET_QK_DIM ** -0.5),
                      heads(rv, RET_HEADS), heads(rg, RET_HEADS))
    o_fox = forgetting_attention(heads(fq, FOX_HEADS), heads(fk, FOX_HEADS), heads(fv, FOX_HEADS),
                                 ff + fox_f_bias)
    gates = jax.nn.sigmoid(mg.astype(jnp.float32)).reshape(B, T, 3, D_MODEL)
    merged = (gates[:, :, 0] * (o_nsa @ w_read_nsa)
              + gates[:, :, 1] * (o_ret @ w_read_ret)
              + gates[:, :, 2] * (o_fox @ w_read_fox))
    return (merged @ w_out).astype(h.dtype)


def swiglu(h, w1, w3, w2):
    return (jax.nn.silu(h @ w1) * (h @ w3)) @ w2


def moe_ffn(h, w_router, w1, w3, w2):
    logits = (h @ w_router).astype(jnp.float32)
    top_v, top_i = lax.top_k(logits, TOP_K)
    top_w = jax.nn.softmax(top_v, axis=-1)
    gate = jnp.sum(jax.nn.one_hot(top_i, N_EXPERTS, dtype=jnp.float32) * top_w[..., None], axis=-2).astype(h.dtype)
    y = jnp.zeros_like(h)
    for e in range(N_EXPERTS):
        y = y + gate[..., e:e + 1] * swiglu(h, w1[e], w3[e], w2[e])
    return y


def setup_inputs(seed: int = 0) -> dict:
    key = jax.random.key(seed)
    keys = iter(jax.random.split(key, 32))

    def nrm(shape, scale):
        return jax.random.normal(next(keys), shape, jnp.float32) * scale

    D = D_MODEL
    L_dh = CMP_LEN * HEAD_DIM
    return {
        'x': nrm((BATCH, SEQ, D), 1.0),
        'c': nrm((BATCH, D), 1.0),
        'ada_w': nrm((DEPTH, D, 6 * D), 0.5 * D ** -0.5),
        'ada_b': nrm((DEPTH, 6 * D), 0.02),
        'norm_mix': 1.0 + nrm((DEPTH, D), 0.02),
        'norm_ffn': 1.0 + nrm((DEPTH, D), 0.02),
        'w_in': nrm((DEPTH, D, D_IN), D ** -0.5),
        'cmp_k_pe': nrm((DEPTH, CMP_LEN, HEAD_DIM), 0.1),
        'cmp_k_w1': nrm((DEPTH, L_dh, CMP_HIDDEN), L_dh ** -0.5),
        'cmp_k_w2': nrm((DEPTH, CMP_HIDDEN, HEAD_DIM), CMP_HIDDEN ** -0.5),
        'cmp_v_pe': nrm((DEPTH, CMP_LEN, HEAD_DIM), 0.1),
        'cmp_v_w1': nrm((DEPTH, L_dh, CMP_HIDDEN), L_dh ** -0.5),
        'cmp_v_w2': nrm((DEPTH, CMP_HIDDEN, HEAD_DIM), CMP_HIDDEN ** -0.5),
        'fox_f_bias': 3.0 + nrm((DEPTH, FOX_HEADS), 0.5),
        'w_read_nsa': nrm((DEPTH, NSA_Q, D), NSA_Q ** -0.5),
        'w_read_ret': nrm((DEPTH, RET_V, D), RET_V ** -0.5),
        'w_read_fox': nrm((DEPTH, FOX_W, D), FOX_W ** -0.5),
        'w_out': nrm((DEPTH, D, D), D ** -0.5),
        'ffn_w1': nrm((N_DENSE, D, D_FF), D ** -0.5),
        'ffn_w3': nrm((N_DENSE, D, D_FF), D ** -0.5),
        'ffn_w2': nrm((N_DENSE, D_FF, D), D_FF ** -0.5),
        'router_w': nrm((N_MOE, D, N_EXPERTS), D ** -0.5),
        'moe_w1': nrm((N_MOE, N_EXPERTS, D, D_FF_EXPERT), D ** -0.5),
        'moe_w3': nrm((N_MOE, N_EXPERTS, D, D_FF_EXPERT), D ** -0.5),
        'moe_w2': nrm((N_MOE, N_EXPERTS, D_FF_EXPERT, D), D_FF_EXPERT ** -0.5),
        'final_norm': 1.0 + nrm((D,), 0.02),
    }


def reference(x, c, ada_w, ada_b, norm_mix, norm_ffn, w_in, cmp_k_pe, cmp_k_w1, cmp_k_w2,
              cmp_v_pe, cmp_v_w1, cmp_v_w2, fox_f_bias, w_read_nsa, w_read_ret, w_read_fox, w_out,
              ffn_w1, ffn_w3, ffn_w2, router_w, moe_w1, moe_w3, moe_w2, final_norm):
    for l in range(DEPTH):
        mod = jax.nn.silu(c) @ ada_w[l] + ada_b[l]
        sh1, sc1, g1, sh2, sc2, g2 = jnp.split(mod[:, None, :], 6, axis=-1)
        h = rms_norm(x, norm_mix[l]) * (1.0 + sc1) + sh1
        x = x + g1 * token_mixing(h, w_in[l], cmp_k_pe[l], cmp_k_w1[l], cmp_k_w2[l],
                                  cmp_v_pe[l], cmp_v_w1[l], cmp_v_w2[l], fox_f_bias[l],
                                  w_read_nsa[l], w_read_ret[l], w_read_fox[l], w_out[l])
        h = rms_norm(x, norm_ffn[l]) * (1.0 + sc2) + sh2
        if l % 2 == 0:
            f = swiglu(h, ffn_w1[l // 2], ffn_w3[l // 2], ffn_w2[l // 2])
        else:
            f = moe_ffn(h, router_w[l // 2], moe_w1[l // 2], moe_w3[l // 2], moe_w2[l // 2])
        x = x + g2 * f
    return rms_norm(x, final_norm)
```

```cpp
#include <hip/hip_runtime.h>
#include <cstdio>
#include <cstdint>

#ifndef REP_CONV
#define REP_CONV 1
#endif
#ifndef REP_RL
#define REP_RL 1
#endif
#ifndef REP_ROPE
#define REP_ROPE 1
#endif
#ifndef REP_SCAN
#define REP_SCAN 1
#endif
#ifndef REP_TR
#define REP_TR 1
#endif
#ifndef REP_FFN
#define REP_FFN 1
#endif
#ifndef REP_MERGE
#define REP_MERGE 1
#endif
#ifndef REP_NORM
#define REP_NORM 1
#endif
#ifndef REP_CMP
#define REP_CMP 1
#endif
#ifndef REP_FOX
#define REP_FOX 1
#endif
#ifndef REP_NSA
#define REP_NSA 1
#endif
#ifndef REP_RET
#define REP_RET 1
#endif
#ifndef REP_PROJ
#define REP_PROJ 1
#endif
#ifndef MK_MULTI
#define MK_MULTI 0
#endif

namespace pg8 {
#define PG8_LAS __attribute__((address_space(3)))
typedef unsigned short bf16_t;
typedef short bf16x8 __attribute__((ext_vector_type(8)));
typedef float f32x4 __attribute__((ext_vector_type(4)));
typedef unsigned u32x4 __attribute__((ext_vector_type(4)));
typedef unsigned u32x2 __attribute__((ext_vector_type(2)));
constexpr int BM = 256, BK = 64, HALF = 128, HTB = HALF * BK * 2, STAGE_BYTES = 8 * HTB, NXCD = 8, WGM = 8;

__host__ __device__ __forceinline__ int lds_byte(int r, int c) { const int st = (r >> 4) * 2 + (c >> 5), rr = r & 15, cc = c & 31, ob = rr * 64 + cc * 2; return st * 1024 + (ob ^ (((ob >> 9) & 1) << 5)); }
__host__ __device__ __forceinline__ void stage_rc(int b, int& R, int& C) { const int st = b / 1024, sb = b % 1024, swz = sb ^ (((sb >> 9) & 1) << 5); R = (st >> 1) * 16 + swz / 64; C = (st & 1) * 32 + (swz % 64) / 2; }
__host__ __device__ __forceinline__ int perm32(int rho) { const int n = rho >> 4, i = rho & 15; return 8 * (i >> 2) + 4 * n + (i & 3); }

struct Unit { int pm, pn, ks; };
struct Gemm { const bf16_t* A; const bf16_t* Bt; int lda, ldb, K; };

struct StaticOrder {
    int nM, nN, nwg, G, c;
    __device__ void init(int M, int N, int G_, int c_) { nM = M / BM; nN = N / BM; nwg = nM * nN; G = G_; c = c_; }
    __device__ bool next(int i, Unit& u) const {
        const long L = (long)i * G + c; if (L >= nwg) return false;
        int wgid = (int)L; { const int q = nwg / NXCD, r = nwg % NXCD, xcd = wgid % NXCD, off = wgid / NXCD; wgid = (xcd < r ? xcd * (q + 1) : r * (q + 1) + (xcd - r) * q) + off; }
        const int nig = WGM * nN, gid = wgid / nig, fm = gid * WGM, gsz = (nM - fm) < WGM ? (nM - fm) : WGM;
        u.pm = fm + ((wgid % nig) % gsz); u.pn = (wgid % nig) / gsz; u.ks = 0; return true;
    }
};
struct CmpOrder {
    int G, c;
    __device__ bool next(int i, Unit& u) const { if (i != 0 || c >= 64) return false; const int L = c & 15; u.pm = L; u.pn = L >> 3; u.ks = 0; return true; }
};
struct MoeOrder {
    int G, c, ncol, ntiles; const PG8_LAS int* toff;
    __device__ bool next(int i, Unit& u) const {
        const int L = i * G + c; if (L >= ntiles * ncol) return false;
        const int rt = L / ncol, pnl = L - rt * ncol; int e = 0;
#pragma unroll
        for (int k = 1; k < 8; ++k) e += (rt >= toff[k]) ? 1 : 0;
        u.pm = rt; u.pn = e * ncol + pnl; u.ks = 0; return true;
    }
};
struct MoeDownOrder {
    int G, c, ntiles, ksbytes; const PG8_LAS int* toff;
    __device__ bool next(int i, Unit& u) const {
        const int L = i * G + c; if (L >= ntiles * 8) return false;
        const int rt = L >> 3, sl = (L >> 2) & 1, pnl = L & 3; int e = 0;
#pragma unroll
        for (int k = 1; k < 8; ++k) e += (rt >= toff[k]) ? 1 : 0;
        u.pm = rt; u.pn = e * 4 + pnl; u.ks = sl * ksbytes; return true;
    }
};

__device__ __forceinline__ unsigned cvt_pk_bf16(float lo, float hi) { unsigned r; asm volatile("v_cvt_pk_bf16_f32 %0, %1, %2" : "=v"(r) : "v"(lo), "v"(hi)); return r; }
__device__ __forceinline__ float bflo(unsigned w) { return __uint_as_float(w << 16); }
__device__ __forceinline__ float bfhi(unsigned w) { return __uint_as_float(w & 0xffff0000u); }
__device__ __forceinline__ float sigmoidf_(float x) { return __builtin_amdgcn_rcpf(1.0f + __expf(-x)); }
__device__ __forceinline__ float siluf_(float x) { return x * sigmoidf_(x); }


struct EpiProj {
    static constexpr bool PERM = true;
    unsigned char* wsb; unsigned o_nq, o_kv, o_ret, o_fox, o_mg, o_small;
    __device__ __forceinline__ void operator()(const f32x4 (&acc)[2][2][4][2], const Unit& u, int wr, int wc, int fr, int fq) const {
        const int row0 = u.pm * BM + wr * 64 + fr; const int pn = u.pn;
        if (pn == 29) {
            if (wc == 0) {
#pragma unroll
                for (int ai = 0; ai < 2; ++ai)
#pragma unroll
                    for (int m = 0; m < 4; ++m) { float* p = (float*)(wsb + o_small) + (size_t)(row0 + ai * HALF + m * 16) * 32 + 8 * fq; *(f32x4*)p = acc[ai][0][m][0]; *(f32x4*)(p + 4) = acc[ai][0][m][1]; }
            }
            return;
        }
        unsigned bo; int ldc, colt; bool sig = false;
        if (pn < 2) { bo = o_nq; ldc = 512; colt = pn * 256; }
        else if (pn < 5) { bo = o_kv; ldc = 768; colt = (pn - 2) * 256; }
        else if (pn < 11) { bo = o_ret; ldc = 1536; colt = (pn - 5) * 256; }
        else if (pn < 17) { bo = o_fox; ldc = 1536; colt = (pn - 11) * 256; }
        else { bo = o_mg; ldc = 3072; colt = (pn - 17) * 256; sig = true; }
        bf16_t* base = (bf16_t*)(wsb + bo);
        const int col0 = colt + wc * 32 + 8 * fq;
#pragma unroll
        for (int ai = 0; ai < 2; ++ai)
#pragma unroll
            for (int m = 0; m < 4; ++m) { bf16_t* rowp = base + (size_t)(row0 + ai * HALF + m * 16) * ldc + col0;
#pragma unroll
                for (int bj = 0; bj < 2; ++bj) { f32x4 v0 = acc[ai][bj][m][0], v1 = acc[ai][bj][m][1];
                    if (sig) {
#pragma unroll
                        for (int e = 0; e < 4; ++e) { v0[e] = sigmoidf_(v0[e]); v1[e] = sigmoidf_(v1[e]); } }
                    u32x4 w; w.x = cvt_pk_bf16(v0[0], v0[1]); w.y = cvt_pk_bf16(v0[2], v0[3]); w.z = cvt_pk_bf16(v1[0], v1[1]); w.w = cvt_pk_bf16(v1[2], v1[3]);
                    *(u32x4*)(rowp + bj * HALF) = w; } }
    }
};
struct EpiHid {
    static constexpr bool PERM = true;
    bf16_t* hid; const float* bias1;
    __device__ __forceinline__ void operator()(const f32x4 (&acc)[2][2][4][2], const Unit& u, int wr, int wc, int fr, int fq) const {
        const int row0 = u.pm * BM + wr * 64 + fr; const int col0 = wc * 32 + 8 * fq; const float* bb = bias1 + u.pn * 256;
#pragma unroll
        for (int ai = 0; ai < 2; ++ai)
#pragma unroll
            for (int m = 0; m < 4; ++m) { bf16_t* rowp = hid + (size_t)(row0 + ai * HALF + m * 16) * 256 + col0;
#pragma unroll
                for (int bj = 0; bj < 2; ++bj) { const f32x4 b0 = *(const f32x4*)(bb + col0 + bj * HALF), b1 = *(const f32x4*)(bb + col0 + bj * HALF + 4);
                    f32x4 v0 = acc[ai][bj][m][0] + b0, v1 = acc[ai][bj][m][1] + b1;
#pragma unroll
                    for (int e = 0; e < 4; ++e) { v0[e] = siluf_(v0[e]); v1[e] = siluf_(v1[e]); }
                    u32x4 w; w.x = cvt_pk_bf16(v0[0], v0[1]); w.y = cvt_pk_bf16(v0[2], v0[3]); w.z = cvt_pk_bf16(v1[0], v1[1]); w.w = cvt_pk_bf16(v1[2], v1[3]);
                    *(u32x4*)(rowp + bj * HALF) = w; } }
    }
};
struct EpiPart {
    static constexpr bool PERM = true;
    float* part;
    __device__ __forceinline__ void operator()(const f32x4 (&acc)[2][2][4][2], const Unit& u, int wr, int wc, int fr, int fq) const {
        const int row0 = u.pm * BM + wr * 64 + fr; const int col0 = wc * 32 + 8 * fq;
#pragma unroll
        for (int ai = 0; ai < 2; ++ai)
#pragma unroll
            for (int m = 0; m < 4; ++m) { float* rowp = part + (size_t)(row0 + ai * HALF + m * 16) * 256 + col0;
#pragma unroll
                for (int bj = 0; bj < 2; ++bj) { *(f32x4*)(rowp + bj * HALF) = acc[ai][bj][m][0]; *(f32x4*)(rowp + bj * HALF + 4) = acc[ai][bj][m][1]; } }
    }
};
template <int ACCUM> struct EpiMerge {
    static constexpr bool PERM = true;
    const bf16_t* gate; bf16_t* out;
    __device__ __forceinline__ void operator()(const f32x4 (&acc)[2][2][4][2], const Unit& u, int wr, int wc, int fr, int fq) const {
        const int row0 = u.pm * BM + wr * 64 + fr; const int col0 = u.pn * BM + wc * 32 + 8 * fq;
#pragma unroll
        for (int ai = 0; ai < 2; ++ai)
#pragma unroll
            for (int m = 0; m < 4; ++m) { const size_t row = (size_t)(row0 + ai * HALF + m * 16);
#pragma unroll
                for (int bj = 0; bj < 2; ++bj) { const int col = col0 + bj * HALF;
                    const u32x4 g = *(const u32x4*)(gate + row * 3072 + col);
                    f32x4 v0 = acc[ai][bj][m][0], v1 = acc[ai][bj][m][1];
                    v0[0] *= bflo(g.x); v0[1] *= bfhi(g.x); v0[2] *= bflo(g.y); v0[3] *= bfhi(g.y); v1[0] *= bflo(g.z); v1[1] *= bfhi(g.z); v1[2] *= bflo(g.w); v1[3] *= bfhi(g.w);
                    if (ACCUM) { const u32x4 o = *(const u32x4*)(out + row * 1024 + col);
                        v0[0] += bflo(o.x); v0[1] += bfhi(o.x); v0[2] += bflo(o.y); v0[3] += bfhi(o.y); v1[0] += bflo(o.z); v1[1] += bfhi(o.z); v1[2] += bflo(o.w); v1[3] += bfhi(o.w); }
                    u32x4 w; w.x = cvt_pk_bf16(v0[0], v0[1]); w.y = cvt_pk_bf16(v0[2], v0[3]); w.z = cvt_pk_bf16(v1[0], v1[1]); w.w = cvt_pk_bf16(v1[2], v1[3]);
                    *(u32x4*)(out + row * 1024 + col) = w; } }
    }
};
struct EpiMergeS {
    static constexpr bool PERM = true;
    const bf16_t* gate; bf16_t* out;
    __device__ __forceinline__ void operator()(const f32x4 (&acc)[2][2][4][2], const Unit& u, int wr, int wc, int fr, int fq) const {
        const int seg = u.pm >> 6; const int row0 = (u.pm & 63) * BM + wr * 64 + fr; const int col0 = (u.pn & 3) * BM + wc * 32 + 8 * fq;
#pragma unroll
        for (int ai = 0; ai < 2; ++ai) {
            u32x4 g[4][2], o[4][2];
#pragma unroll
            for (int m = 0; m < 4; ++m) { const size_t row = (size_t)(row0 + ai * HALF + m * 16);
#pragma unroll
                for (int bj = 0; bj < 2; ++bj) { const int col = col0 + bj * HALF; g[m][bj] = *(const u32x4*)(gate + row * 3072 + seg * 1024 + col);
                    if (seg > 0) o[m][bj] = *(const u32x4*)(out + row * 1024 + col); else o[m][bj] = (u32x4){0u, 0u, 0u, 0u}; } }
#pragma unroll
            for (int m = 0; m < 4; ++m) { const size_t row = (size_t)(row0 + ai * HALF + m * 16);
#pragma unroll
                for (int bj = 0; bj < 2; ++bj) { const int col = col0 + bj * HALF; const u32x4 gg = g[m][bj], oo = o[m][bj];
                    f32x4 v0 = acc[ai][bj][m][0], v1 = acc[ai][bj][m][1];
                    v0[0] = v0[0] * bflo(gg.x) + bflo(oo.x); v0[1] = v0[1] * bfhi(gg.x) + bfhi(oo.x); v0[2] = v0[2] * bflo(gg.y) + bflo(oo.y); v0[3] = v0[3] * bfhi(gg.y) + bfhi(oo.y);
                    v1[0] = v1[0] * bflo(gg.z) + bflo(oo.z); v1[1] = v1[1] * bfhi(gg.z) + bfhi(oo.z); v1[2] = v1[2] * bflo(gg.w) + bflo(oo.w); v1[3] = v1[3] * bfhi(gg.w) + bfhi(oo.w);
                    u32x4 w; w.x = cvt_pk_bf16(v0[0], v0[1]); w.y = cvt_pk_bf16(v0[2], v0[3]); w.z = cvt_pk_bf16(v1[0], v1[1]); w.w = cvt_pk_bf16(v1[2], v1[3]);
                    *(u32x4*)(out + row * 1024 + col) = w; } }
        }
    }
};
struct MergeOrder {
    StaticOrder so;
    __device__ bool next(int i, Unit& u) const { if (i >= 3) return false; if (!so.next(0, u)) return false; u.pm += 64 * i; u.pn += 4 * i; return true; }
};
template <bool IN_F32> struct EpiResid {
    static constexpr bool PERM = true;
    const float* xin32; const bf16_t* xin; bf16_t* xout; const float* gvec; int gstride;
    __device__ __forceinline__ void operator()(const f32x4 (&acc)[2][2][4][2], const Unit& u, int wr, int wc, int fr, int fq) const {
        const int row0 = u.pm * BM + wr * 64 + fr; const int col0 = u.pn * BM + wc * 32 + 8 * fq; const float* gv = gvec + (size_t)(u.pm >> 5) * gstride;
#pragma unroll
        for (int bj = 0; bj < 2; ++bj) { const int col = col0 + bj * HALF; const f32x4 g0 = *(const f32x4*)(gv + col), g1 = *(const f32x4*)(gv + col + 4);
#pragma unroll
            for (int ai = 0; ai < 2; ++ai) {
                f32x4 x0[4], x1[4];
#pragma unroll
                for (int m = 0; m < 4; ++m) { const size_t off = (size_t)(row0 + ai * HALF + m * 16) * 1024 + col;
                    if (IN_F32) { x0[m] = *(const f32x4*)(xin32 + off); x1[m] = *(const f32x4*)(xin32 + off + 4); }
                    else { const u32x4 w = *(const u32x4*)(xin + off); x0[m] = (f32x4){bflo(w.x), bfhi(w.x), bflo(w.y), bfhi(w.y)}; x1[m] = (f32x4){bflo(w.z), bfhi(w.z), bflo(w.w), bfhi(w.w)}; } }
#pragma unroll
                for (int m = 0; m < 4; ++m) { const size_t off = (size_t)(row0 + ai * HALF + m * 16) * 1024 + col;
                    const f32x4 y0 = x0[m] + g0 * acc[ai][bj][m][0], y1 = x1[m] + g1 * acc[ai][bj][m][1];
                    u32x4 w; w.x = cvt_pk_bf16(y0[0], y0[1]); w.y = cvt_pk_bf16(y0[2], y0[3]); w.z = cvt_pk_bf16(y1[0], y1[1]); w.w = cvt_pk_bf16(y1[2], y1[3]);
                    *(u32x4*)(xout + off) = w; } } }
    }
};
struct EpiSwiglu {
    static constexpr bool PERM = true;
    bf16_t* act; int ldc, ncolt;
    __device__ __forceinline__ void operator()(const f32x4 (&acc)[2][2][4][2], const Unit& u, int wr, int wc, int fr, int fq) const {
        const int row0 = u.pm * BM + wr * 64 + fr; const int pnl = u.pn % ncolt; const int col0 = pnl * 128 + wc * 16 + 4 * fq;
#pragma unroll
        for (int ai = 0; ai < 2; ++ai)
#pragma unroll
            for (int m = 0; m < 4; ++m) { bf16_t* rowp = act + (size_t)(row0 + ai * HALF + m * 16) * ldc + col0;
#pragma unroll
                for (int bj = 0; bj < 2; ++bj) { const f32x4 a = acc[ai][bj][m][0], b = acc[ai][bj][m][1]; f32x4 v;
#pragma unroll
                    for (int e = 0; e < 4; ++e) v[e] = siluf_(a[e]) * b[e];
                    u32x2 w; w.x = cvt_pk_bf16(v[0], v[1]); w.y = cvt_pk_bf16(v[2], v[3]); *(u32x2*)(rowp + bj * 64) = w; } }
    }
};
struct EpiY {
    static constexpr bool PERM = true;
    bf16_t* y; bf16_t* y1; const float* sw;
    __device__ __forceinline__ void operator()(const f32x4 (&acc)[2][2][4][2], const Unit& u, int wr, int wc, int fr, int fq) const {
        const int row0 = u.pm * BM + wr * 64 + fr; const int col0 = (u.pn & 3) * BM + wc * 32 + 8 * fq;
#pragma unroll
        for (int ai = 0; ai < 2; ++ai)
#pragma unroll
            for (int m = 0; m < 4; ++m) { const int row = row0 + ai * HALF + m * 16; const float s = sw[row]; bf16_t* rowp = (u.ks ? y1 : y) + (size_t)row * 1024 + col0;
#pragma unroll
                for (int bj = 0; bj < 2; ++bj) { const f32x4 v0 = acc[ai][bj][m][0] * s, v1 = acc[ai][bj][m][1] * s;
                    u32x4 w; w.x = cvt_pk_bf16(v0[0], v0[1]); w.y = cvt_pk_bf16(v0[2], v0[3]); w.z = cvt_pk_bf16(v1[0], v1[1]); w.w = cvt_pk_bf16(v1[2], v1[3]);
                    *(u32x4*)(rowp + bj * HALF) = w; } }
    }
};

template <class Epi, class Sched, bool ALIGN_EPI>
__device__ __forceinline__ void gemm_phase(PG8_LAS unsigned char* lds, const Gemm g, const Sched& S, const Epi& E, const int tid) {
    const int wid = __builtin_amdgcn_readfirstlane(tid >> 6), lane = tid & 63, wr = wid >> 2, wc = wid & 3, fr = lane & 15, fq = lane >> 4;
    const int K = g.K, nt = K / BK, lda = g.lda, ldb = g.ldb;
    unsigned voffA[2], voffB[2];
#pragma unroll
    for (int i = 0; i < 2; ++i) { int R, C; stage_rc(tid * 16 + i * 8192, R, C); const int Rb = Epi::PERM ? ((R & ~31) + perm32(R & 31)) : R;
        voffA[i] = (unsigned)(R * lda + C) * 2u; voffB[i] = (unsigned)(Rb * ldb + C) * 2u; }
    const unsigned kstep = (unsigned)(BK * 2);
    const unsigned hstepA = (unsigned)HALF * (unsigned)lda * 2u, tstepA = 2u * hstepA;
    const unsigned hstepB = (unsigned)HALF * (unsigned)ldb * 2u, tstepB = 2u * hstepB;
    const char* const gA = (const char*)g.A; const char* const gB = (const char*)g.Bt;
    const unsigned ldsw = (unsigned)wid * 1024u;
    const int aoff = lds_byte(wr * 64 + fr, fq * 8), boff = lds_byte(wc * 32 + fr, fq * 8);
#define PG8_SA(b, h) (((b) * 2 + (h)) * HTB)
#define PG8_SB(b, h) ((4 + (b) * 2 + (h)) * HTB)
#define PG8_STAGE(bufoff, gbase, soff, voff) do { _Pragma("unroll") for (int _i = 0; _i < 2; ++_i) \
        __builtin_amdgcn_global_load_lds((const unsigned*)((gbase) + (size_t)(unsigned)((voff)[_i] + (unsigned)(soff))), (PG8_LAS unsigned*)(lds + (bufoff) + ldsw + _i * 8192), 16, 0, 0); } while (0)
#define PG8_LDA(dst, b, h) do { _Pragma("unroll") for (int m = 0; m < 4; ++m) _Pragma("unroll") for (int k = 0; k < 2; ++k) dst[m][k] = *(const PG8_LAS bf16x8*)(lds + PG8_SA(b, h) + aoff + m * 2048 + k * 1024); } while (0)
#define PG8_LDB(dst, b, h) do { _Pragma("unroll") for (int n = 0; n < 2; ++n) _Pragma("unroll") for (int k = 0; k < 2; ++k) dst[n][k] = *(const PG8_LAS bf16x8*)(lds + PG8_SB(b, h) + boff + n * 2048 + k * 1024); } while (0)
#define PG8_MMA(ai, bj, At, Bt) do { __builtin_amdgcn_s_setprio(1); _Pragma("unroll") for (int m = 0; m < 4; ++m) _Pragma("unroll") for (int n = 0; n < 2; ++n) _Pragma("unroll") for (int k = 0; k < 2; ++k) \
        acc[ai][bj][m][n] = __builtin_amdgcn_mfma_f32_16x16x32_bf16(Bt[n][k], At[m][k], acc[ai][bj][m][n], 0, 0, 0); __builtin_amdgcn_s_setprio(0); } while (0)
#define PG8_WAIT_V(n) asm volatile("s_waitcnt vmcnt(" #n ")" ::: "memory")
#define PG8_WAIT_L(n) asm volatile("s_waitcnt lgkmcnt(" #n ")" ::: "memory")
#define PG8_BAR __builtin_amdgcn_s_barrier()
#define PG8_SCHED __builtin_amdgcn_sched_barrier(0)
    Unit cur, nxt; int ui = 0;
    if (!S.next(0, cur)) return;
    unsigned cA = (unsigned)cur.pm * tstepA + (unsigned)cur.ks, cB = (unsigned)cur.pn * tstepB + (unsigned)cur.ks;
    PG8_STAGE(PG8_SB(0, 0), gB, cB, voffB); PG8_STAGE(PG8_SB(0, 1), gB, cB + hstepB, voffB); PG8_STAGE(PG8_SA(0, 0), gA, cA, voffA); PG8_STAGE(PG8_SA(0, 1), gA, cA + hstepA, voffA);
    if (wr == 1) PG8_BAR;
    PG8_WAIT_V(2); PG8_BAR;
    PG8_STAGE(PG8_SB(1, 0), gB, cB + kstep, voffB); PG8_STAGE(PG8_SA(1, 0), gA, cA + kstep, voffA); PG8_STAGE(PG8_SB(1, 1), gB, cB + hstepB + kstep, voffB);
    PG8_WAIT_V(6); PG8_BAR;
    for (;;) {
        const bool has_next = S.next(ui + 1, nxt);
        const unsigned nA = has_next ? (unsigned)nxt.pm * tstepA + (unsigned)nxt.ks : cA; const unsigned nB = has_next ? (unsigned)nxt.pn * tstepB + (unsigned)nxt.ks : cB;
        f32x4 acc[2][2][4][2];
        { float z0 = 0.f; asm volatile("" : "+v"(z0));
#pragma unroll
        for (int a = 0; a < 2; ++a)
#pragma unroll
            for (int b = 0; b < 2; ++b)
#pragma unroll
                for (int m = 0; m < 4; ++m)
#pragma unroll
                    for (int n = 0; n < 2; ++n) acc[a][b][m][n] = (f32x4){z0, z0, z0, z0}; }
        for (int t = 0; t < nt; t += 2) {
            bf16x8 At[4][2], B0[2][2], B1[2][2];
            const bool last = (t == nt - 2);
            const unsigned a1 = cA + (unsigned)(t + 1) * kstep;
            const unsigned a2 = last ? nA : cA + (unsigned)(t + 2) * kstep; const unsigned b2 = last ? nB : cB + (unsigned)(t + 2) * kstep;
            const unsigned a3 = a2 + kstep; const unsigned b3 = b2 + kstep;
            PG8_LDB(B0, 0, 0); PG8_LDB(B1, 0, 1); PG8_SCHED; PG8_LDA(At, 0, 0); PG8_STAGE(PG8_SA(1, 1), gA, a1 + hstepA, voffA);
            PG8_WAIT_V(8); PG8_WAIT_L(0); PG8_BAR; PG8_MMA(0, 0, At, B0); PG8_MMA(0, 1, At, B1); PG8_BAR; PG8_SCHED;
            PG8_LDA(At, 0, 1); PG8_STAGE(PG8_SB(0, 0), gB, b2, voffB); PG8_STAGE(PG8_SB(0, 1), gB, b2 + hstepB, voffB); PG8_STAGE(PG8_SA(0, 0), gA, a2, voffA);
            PG8_WAIT_V(8); PG8_WAIT_L(0); PG8_BAR; PG8_MMA(1, 0, At, B0); PG8_MMA(1, 1, At, B1); PG8_BAR; PG8_SCHED;
            PG8_LDB(B0, 1, 0); PG8_LDB(B1, 1, 1); PG8_SCHED; PG8_LDA(At, 1, 0); PG8_STAGE(PG8_SA(0, 1), gA, a2 + hstepA, voffA);
            PG8_WAIT_V(8); PG8_WAIT_L(0); PG8_BAR; PG8_MMA(0, 0, At, B0); PG8_MMA(0, 1, At, B1); PG8_BAR; PG8_SCHED;
            PG8_LDA(At, 1, 1); PG8_STAGE(PG8_SB(1, 0), gB, b3, voffB); PG8_STAGE(PG8_SB(1, 1), gB, b3 + hstepB, voffB); PG8_STAGE(PG8_SA(1, 0), gA, a3, voffA);
            PG8_WAIT_V(8); PG8_WAIT_L(0); PG8_BAR; PG8_MMA(1, 0, At, B0); PG8_MMA(1, 1, At, B1); PG8_BAR; PG8_SCHED;
        }
        if constexpr (ALIGN_EPI) { if (wr == 0) PG8_BAR; }
        E(acc, cur, wr, wc, fr, fq);
        if (!has_next) break;
        cur = nxt; cA = nA; cB = nB; ++ui;
        if constexpr (ALIGN_EPI) { if (wr == 1) PG8_BAR; }
    }
    PG8_WAIT_V(0);
    if constexpr (!ALIGN_EPI) { if (wr == 0) PG8_BAR; }
    PG8_BAR;
#undef PG8_SA
#undef PG8_SB
#undef PG8_STAGE
#undef PG8_LDA
#undef PG8_LDB
#undef PG8_MMA
#undef PG8_WAIT_V
#undef PG8_WAIT_L
#undef PG8_BAR
#undef PG8_SCHED
}
}

constexpr int NWAVES = 8;
constexpr int T = 8192, D = 1024, M = 16384;
constexpr int DIN = 7456, NPROJ = 7680;
constexpr int DFF = 2816, DFE = 3584, NEXP = 8;
constexpr int MOE_ROWS = 34816;
constexpr float NORM_EPS = 1e-6f;

constexpr size_t MiB = 1u << 20, KiB = 1024;
constexpr size_t WS_CTL = 0, CTL_ZERO_BYTES = 1 * MiB;
constexpr size_t WS_MOD = 1 * MiB;
constexpr size_t WS_BIAS1 = 1 * MiB + 128 * KiB;
constexpr size_t WS_SLOTW = 1 * MiB + 256 * KiB;
constexpr size_t WS_BBASE = 1 * MiB + 512 * KiB;
constexpr size_t WS_ROPE = 2 * MiB;
constexpr size_t WS_CUM = 4 * MiB;
constexpr size_t WS_CC = 5 * MiB;
constexpr size_t WS_CCVT = 5 * MiB + 512 * KiB;
constexpr size_t WS_HID = 6 * MiB;
constexpr size_t WS_TOKINFO = 8 * MiB;
constexpr size_t WS_SMALL = 10 * MiB;
constexpr size_t WS_W = 14 * MiB;
constexpr size_t W_WIN = WS_W;
constexpr size_t W_READ = W_WIN + 30 * MiB;
constexpr size_t W_OUT = W_READ + 6 * MiB;
constexpr size_t W_C1 = W_OUT + 4 * MiB;
constexpr size_t W_F13 = W_C1 + 4 * MiB;
constexpr size_t W_F2 = W_F13 + 11 * MiB;
constexpr size_t WS_HG = WS_W;
constexpr size_t WS_H = WS_W + 68 * MiB;
constexpr size_t WS_BIG = WS_H + 32 * MiB;
constexpr size_t B_NQ = WS_BIG;
constexpr size_t B_KV = B_NQ + 16 * MiB;
constexpr size_t B_RET = B_KV + 24 * MiB;
constexpr size_t B_FOX = B_RET + 48 * MiB;
constexpr size_t B_MG = B_FOX + 48 * MiB;
constexpr size_t B_OATT = B_MG + 96 * MiB;
constexpr size_t B_MERGED = B_OATT + 48 * MiB;
constexpr size_t B_CMP = B_MERGED + 32 * MiB;
constexpr size_t B_RL = B_CMP + 9 * MiB;
constexpr size_t B_RS = B_RL + 16 * MiB;
constexpr size_t B_FVT = B_RS + 16 * MiB;
constexpr size_t B_SVT = B_FVT + 16 * MiB;
constexpr size_t B_WVT = B_SVT + 4 * MiB;
constexpr size_t B_RVT = B_WVT + 4 * MiB;
constexpr size_t B_RKT = B_RVT + 16 * MiB;
constexpr size_t B_PART = B_RKT + 8 * MiB;
constexpr size_t B_MIX_END = B_PART + 16 * MiB;
constexpr size_t B_ACT0 = WS_BIG;
constexpr size_t B_MW13 = WS_BIG;
constexpr size_t B_MW2 = B_MW13 + 112 * MiB;
constexpr size_t B_ACT = B_MW2 + 56 * MiB;
constexpr size_t B_MOE_END = B_ACT + (size_t)MOE_ROWS * DFE * 2;
constexpr size_t WS_XR = (B_MOE_END > B_MIX_END ? B_MOE_END : B_MIX_END);
constexpr size_t WS_NEED = WS_XR + 32 * MiB;
constexpr int CW_BAR = 4096;
constexpr int CW_ECNT = 16384;
constexpr int CW_KMAX = 20480;

constexpr int RING_BYTES = 131072;
constexpr int LDSCTL_OFF = RING_BYTES, MISC_OFF = LDSCTL_OFF + 320;
constexpr int LDS_BYTES = 147456;

#define GAS __attribute__((address_space(1)))
#define LAS __attribute__((address_space(3)))
typedef unsigned short bf16;
typedef unsigned v4u __attribute__((ext_vector_type(4)));
typedef unsigned v2u __attribute__((ext_vector_type(2)));
typedef float f32x4 __attribute__((ext_vector_type(4)));
typedef float f32x2 __attribute__((ext_vector_type(2)));
typedef GAS unsigned gu32;
#define RLX_AGENT __ATOMIC_RELAXED, __HIP_MEMORY_SCOPE_AGENT
#define LDS_WAIT() asm volatile("s_waitcnt lgkmcnt(0)" ::: "memory")
#define VM_WAIT() asm volatile("s_waitcnt vmcnt(0)" ::: "memory")
__device__ __forceinline__ unsigned f2bf(float f) { unsigned u = __builtin_bit_cast(unsigned, f); return (u + 0x7fffu + ((u >> 16) & 1u)) >> 16; }
__device__ __forceinline__ unsigned pk2(float lo, float hi) { return f2bf(lo) | (f2bf(hi) << 16); }
__device__ __forceinline__ float bf2f(bf16 h) { return __uint_as_float(((unsigned)h) << 16); }
__device__ __forceinline__ float blo(unsigned w) { return __uint_as_float(w << 16); }
__device__ __forceinline__ float bhi(unsigned w) { return __uint_as_float(w & 0xffff0000u); }

#define XB_TMO      128
#define XB_XCNT(j)  (256  + 64 * (j))
#define XB_XSUB(j)  (1280 + 64 * (j))
#define XB_XGEN(j)  (2304 + 64 * (j))
#define XB_TOP      3328
#define XB_TOPGEN   3392
#define XCD_BAR_WORDS 3456
#define XB_SPIN_CAP (1u << 18)
__device__ __forceinline__ unsigned xb_ld(unsigned* p)              { return __hip_atomic_load(p, __ATOMIC_RELAXED, __HIP_MEMORY_SCOPE_AGENT); }
__device__ __forceinline__ unsigned xb_add(unsigned* p, unsigned v) { return __hip_atomic_fetch_add(p, v, __ATOMIC_RELAXED, __HIP_MEMORY_SCOPE_AGENT); }
__device__ __forceinline__ unsigned xb_xcc_id() { return (unsigned)__builtin_amdgcn_s_getreg((3 << 11) | 20) & 0xFu; }
#define XB_SPIN(cond, bar) do { unsigned _sp = 0; while (cond) { __builtin_amdgcn_s_sleep(1); \
    if ((++_sp & 255u) == 0u) { if (xb_ld(&(bar)[XB_TMO])) break; if (_sp > XB_SPIN_CAP) { atomicAdd(&(bar)[XB_TMO], 1u); break; } } } } while (0)
struct XcdBarrier { unsigned* bar; unsigned x; volatile LAS unsigned* st; };
__device__ __forceinline__ XcdBarrier xcd_barrier_post(unsigned* bar, volatile LAS unsigned* st) {
    XcdBarrier b; b.bar = bar; b.x = xb_xcc_id(); b.st = st;
    if (threadIdx.x == 0) (void)xb_add(&bar[XB_XCNT(b.x)], 1u);
    return b;
}
__device__ __forceinline__ void xcd_barrier_complete(unsigned* bar, unsigned x, unsigned& nloc, unsigned& nx) {
    const unsigned G = gridDim.x * gridDim.y * gridDim.z;
    unsigned sum, cnt, mine, sp = 0u;
    for (;;) {
        sum = 0u; cnt = 0u; mine = 0u;
#pragma unroll
        for (unsigned j = 0; j < 16; ++j) { const unsigned c = xb_ld(&bar[XB_XCNT(j)]); sum += c; cnt += (c > 0u) ? 1u : 0u; mine = (j == x) ? c : mine; }
        if (sum == G) break;
        __builtin_amdgcn_s_sleep(1);
        if ((++sp & 255u) == 0u) { if (xb_ld(&bar[XB_TMO])) break; if (sp > XB_SPIN_CAP) { atomicAdd(&bar[XB_TMO], 1u); break; } }
    }
    nloc = mine > 0u ? mine : 1u; nx = cnt > 0u ? cnt : 1u;
}
__device__ __forceinline__ void xcd_barrier(const XcdBarrier& b) {
    asm volatile("s_waitcnt vmcnt(0)" ::: "memory");
    __syncthreads();
    if (threadIdx.x == 0) {
        unsigned* bar = b.bar;
        __builtin_amdgcn_s_waitcnt(0);
        unsigned nloc = b.st[0], nx = b.st[1];
        if (nloc == 0u) { xcd_barrier_complete(bar, b.x, nloc, nx); b.st[0] = nloc; b.st[1] = nx; }
        const unsigned old = xb_add(&bar[XB_XSUB(b.x)], 1u);
        const unsigned gen = old / nloc;
        if (old + 1u == (gen + 1u) * nloc) {
            __builtin_amdgcn_fence(__ATOMIC_RELEASE, "agent");
            asm volatile("s_waitcnt vmcnt(0)" ::: "memory");
            const unsigned og = xb_add(&bar[XB_TOP], 1u);
            const unsigned tg = og / nx;
            if (og + 1u == (tg + 1u) * nx) xb_add(&bar[XB_TOPGEN], 1u);
            else XB_SPIN(xb_ld(&bar[XB_TOPGEN]) == tg, bar);
            __builtin_amdgcn_fence(__ATOMIC_ACQUIRE, "agent");
            xb_add(&bar[XB_XGEN(b.x)], 1u);
            asm volatile("s_waitcnt vmcnt(0)" ::: "memory");
        } else {
            XB_SPIN(xb_ld(&bar[XB_XGEN(b.x)]) == gen, bar);
            __builtin_amdgcn_fence(__ATOMIC_ACQUIRE, "agent");
            asm volatile("s_waitcnt vmcnt(0)" ::: "memory");
        }
    }
    __syncthreads();
}

template <int CTRL> __device__ __forceinline__ float dpp_f(float v) { return __builtin_bit_cast(float, __builtin_amdgcn_update_dpp(0, __builtin_bit_cast(int, v), CTRL, 0xf, 0xf, true)); }
template <int CTRL> __device__ __forceinline__ int dpp_i(int v) { return __builtin_amdgcn_update_dpp(0, v, CTRL, 0xf, 0xf, true); }
__device__ __forceinline__ float wave_sum(float v) {
    v += dpp_f<0xB1>(v); v += dpp_f<0x4E>(v); v += dpp_f<0x141>(v); v += dpp_f<0x140>(v);
    { auto r = __builtin_amdgcn_permlane16_swap(__float_as_uint(v), __float_as_uint(v), false, false); v = __uint_as_float(r[0]) + __uint_as_float(r[1]); }
    { auto r = __builtin_amdgcn_permlane32_swap(__float_as_uint(v), __float_as_uint(v), false, false); v = __uint_as_float(r[0]) + __uint_as_float(r[1]); }
    return v;
}
__device__ __forceinline__ float wave_max(float v) {
    v = fmaxf(v, dpp_f<0xB1>(v)); v = fmaxf(v, dpp_f<0x4E>(v)); v = fmaxf(v, dpp_f<0x141>(v)); v = fmaxf(v, dpp_f<0x140>(v));
    { auto r = __builtin_amdgcn_permlane16_swap(__float_as_uint(v), __float_as_uint(v), false, false); v = fmaxf(__uint_as_float(r[0]), __uint_as_float(r[1])); }
    { auto r = __builtin_amdgcn_permlane32_swap(__float_as_uint(v), __float_as_uint(v), false, false); v = fmaxf(__uint_as_float(r[0]), __uint_as_float(r[1])); }
    return v;
}
__device__ __forceinline__ int imin_(int a, int b) { return a < b ? a : b; }
__device__ __forceinline__ int wave_min_i(int v) {
    v = imin_(v, dpp_i<0xB1>(v)); v = imin_(v, dpp_i<0x4E>(v)); v = imin_(v, dpp_i<0x141>(v)); v = imin_(v, dpp_i<0x140>(v));
    { auto r = __builtin_amdgcn_permlane16_swap((unsigned)v, (unsigned)v, false, false); v = imin_((int)r[0], (int)r[1]); }
    { auto r = __builtin_amdgcn_permlane32_swap((unsigned)v, (unsigned)v, false, false); v = imin_((int)r[0], (int)r[1]); }
    return v;
}
__device__ __forceinline__ float half_sum(float v) { auto r = __builtin_amdgcn_permlane32_swap(__float_as_uint(v), __float_as_uint(v), false, false); return __uint_as_float(r[0]) + __uint_as_float(r[1]); }
#define WAVE_SYNC() do { asm volatile("s_waitcnt lgkmcnt(0)" ::: "memory"); __builtin_amdgcn_wave_barrier(); } while (0)

struct Ptrs {
    const float* in[26];
    float* out; unsigned char* ws;
    int ph_lo, ph_hi;
};
enum { I_X = 0, I_C, I_ADAW, I_ADAB, I_NMIX, I_NFFN, I_WIN, I_CKPE, I_CKW1, I_CKW2, I_CVPE, I_CVW1, I_CVW2, I_FBIAS, I_RNSA, I_RRET, I_RFOX, I_WOUT,
       I_FW1, I_FW3, I_FW2, I_ROUTER, I_MW1, I_MW3, I_MW2, I_FNORM };

template <int MAP> __device__ __forceinline__ const float* tj_src(const float* W0, const float* W1, int p) {
    if (MAP == 0) return W0 + p;
    if (MAP == 2) { const int G = p >> 5, c = p & 31; const int col = 16 * G + (c >> 3) * 4 + (c & 3); return (((c >> 2) & 1) ? W1 : W0) + col; }
    if (p < 1280) return W0 + p;
    if (p < 4352) return W0 + p + 24;
    if (p < 7424) return W0 + p + 32;
    const int i = p - 7424; if (i < 24) return W0 + 1280 + i; if (i < 32) return W0 + 4376 + (i - 24); return nullptr;
}
template <int MAP> __device__ __forceinline__ void transpose_item(const float* W0, const float* W1, int ldw, int K, bf16* WT, int ndest, int item, LAS float* scr, int lane) {
    const int nblk = ndest / 64, kb = item / nblk, nb = item - kb * nblk, k0 = 64 * kb, n0 = 64 * nb;
    const int kr2 = lane >> 4, n4 = lane & 15;
    const float* src0 = tj_src<MAP>(W0, W1, n0 + 4 * n4); const bool has = (MAP != 1) || (src0 != nullptr); const float* src = has ? src0 : W0;
    LAS unsigned* sc = (LAS unsigned*)scr;
    f32x4 a[8], b[8];
#pragma unroll
    for (int i = 0; i < 8; ++i) { const int k = k0 + 8 * i + 2 * kr2;
        const f32x4 va = *(const f32x4*)(src + (size_t)k * ldw), vb = *(const f32x4*)(src + (size_t)(k + 1) * ldw); const f32x4 z4 = {0.f, 0.f, 0.f, 0.f};
        a[i] = has ? va : z4; b[i] = has ? vb : z4; }
#pragma unroll
    for (int i = 0; i < 8; ++i) { const int kd = 4 * i + kr2;
        sc[(4 * n4 + 0) * 33 + kd] = pk2(a[i].x, b[i].x); sc[(4 * n4 + 1) * 33 + kd] = pk2(a[i].y, b[i].y); sc[(4 * n4 + 2) * 33 + kd] = pk2(a[i].z, b[i].z); sc[(4 * n4 + 3) * 33 + kd] = pk2(a[i].w, b[i].w); }
    LDS_WAIT(); asm volatile("" ::: "memory");
    const int c = lane & 7;
#pragma unroll
    for (int q = 0; q < 8; ++q) { const int n = (lane >> 3) + 8 * q; const LAS unsigned* s = sc + n * 33 + 4 * c;
        const v4u o = {s[0], s[1], s[2], s[3]};
        *(GAS v4u*)(WT + (size_t)(n0 + n) * K + k0 + 8 * c) = o; }
    LDS_WAIT(); asm volatile("" ::: "memory");
}
__device__ __forceinline__ int tj_items(int K, int ndest) { return (K / 64) * (ndest / 64); }

template <int R> __device__ __forceinline__ void att_scores(const char* kblk, unsigned koff, const LAS float* qs, float (&s)[R]) {
#pragma unroll
    for (int r = 0; r < R; ++r) s[r] = 0.f;
    v4u kq[8];
#pragma unroll
    for (int c = 0; c < 8; ++c) kq[c] = *(const v4u*)(kblk + (size_t)koff + 16 * c);
#pragma unroll
    for (int c = 0; c < 8; ++c) {
        const v4u kv = kq[c];
        const float k0 = blo(kv.x), k1 = bhi(kv.x), k2 = blo(kv.y), k3 = bhi(kv.y), k4 = blo(kv.z), k5 = bhi(kv.z), k6 = blo(kv.w), k7 = bhi(kv.w);
#pragma unroll
        for (int r = 0; r < R; ++r) { const f32x4 q0 = *(const LAS f32x4*)(qs + r * 64 + 8 * c), q1 = *(const LAS f32x4*)(qs + r * 64 + 8 * c + 4);
            s[r] += k0 * q0.x + k1 * q0.y + k2 * q0.z + k3 * q0.w + k4 * q1.x + k5 * q1.y + k6 * q1.z + k7 * q1.w; }
#pragma unroll
        for (int r = 0; r < R; ++r) asm volatile("" : "+v"(s[r]));
    }
}
template <int R, int LDVB> __device__ __forceinline__ void att_pv64(const char* vblk, unsigned loff, const LAS float* pb, float (&o)[R][2], int kh) {
#pragma unroll 2
    for (int kk = 0; kk < 32; kk += 4) {
        f32x4 p[R];
#pragma unroll
        for (int r = 0; r < R; ++r) p[r] = *(const LAS f32x4*)(pb + r * 64 + kh * 32 + kk);
#pragma unroll
        for (int q = 0; q < 4; ++q) { const unsigned w = *(const unsigned*)(vblk + (size_t)(2 * (kk + q)) * LDVB + (size_t)loff); const float v0 = blo(w), v1 = bhi(w);
#pragma unroll
            for (int r = 0; r < R; ++r) { o[r][0] += p[r][q] * v0; o[r][1] += p[r][q] * v1; } }
    }
}
template <int R> __device__ __forceinline__ void att_softmax_step(float (&s)[R], float (&m)[R], float (&l)[R], float (&o)[R][2], LAS float* pb, int lane) {
    const int slot = (lane & 1) * 32 + (lane >> 1);
#pragma unroll
    for (int r = 0; r < R; ++r) {
        const float bm = wave_max(s[r]); const float mn = fmaxf(m[r], bm);
        float p = 0.f, alpha = 1.f;
        if (mn > -INFINITY) { alpha = __expf(m[r] - mn); p = __expf(s[r] - mn); }
        l[r] = l[r] * alpha + p; o[r][0] *= alpha; o[r][1] *= alpha; m[r] = mn; pb[r * 64 + slot] = p;
    }
}

namespace fa {
typedef short bf16x8 __attribute__((ext_vector_type(8)));
typedef float f32x16 __attribute__((ext_vector_type(16)));
constexpr int ROWB = 144;
constexpr int TILEB = 64 * ROWB;
constexpr int OFF_K = 0, OFF_V = 2 * TILEB, OFF_B = 4 * TILEB, OFF_W = OFF_B + 512, WAVEB = 4608;
constexpr float C2 = 0.125f * 1.4426950408889634f;
__device__ __forceinline__ int crow(int r, int hi) { return (r & 3) + 8 * (r >> 2) + 4 * hi; }
__device__ __forceinline__ int perm16(int t) { const int q4 = (t >> 2) & 3; return (q4 == 1) ? t + 4 : (q4 == 2) ? t - 4 : t; }
typedef float f32x2_t __attribute__((ext_vector_type(2))); typedef __bf16 bf16x2_t __attribute__((ext_vector_type(2)));
__device__ __forceinline__ unsigned cvtpk(float lo, float hi) { f32x2_t v = {lo, hi}; bf16x2_t b = __builtin_convertvector(v, bf16x2_t); return __builtin_bit_cast(unsigned, b); }
__device__ __forceinline__ float hmax(float v) { auto r = __builtin_amdgcn_permlane32_swap(__float_as_uint(v), __float_as_uint(v), false, false); return fmaxf(__uint_as_float(r[0]), __uint_as_float(r[1])); }

__device__ __forceinline__ void qk_tile(f32x16& p0, f32x16& p1, const LAS char* kb, const bf16x8 (&qr)[4], const f32x16& c0, const f32x16& c1) {
    bf16x8 a0[4], a1[4];
#pragma unroll
    for (int d0 = 0; d0 < 4; ++d0) { a0[d0] = *(const LAS bf16x8*)(kb + 32 * d0); a1[d0] = *(const LAS bf16x8*)(kb + 32 * ROWB + 32 * d0); }
    p0 = __builtin_amdgcn_mfma_f32_32x32x16_bf16(a0[0], qr[0], c0, 0, 0, 0); p1 = __builtin_amdgcn_mfma_f32_32x32x16_bf16(a1[0], qr[0], c1, 0, 0, 0);
#pragma unroll
    for (int d0 = 1; d0 < 4; ++d0) { p0 = __builtin_amdgcn_mfma_f32_32x32x16_bf16(a0[d0], qr[d0], p0, 0, 0, 0); p1 = __builtin_amdgcn_mfma_f32_32x32x16_bf16(a1[d0], qr[d0], p1, 0, 0, 0); }
}
struct VFrag { bf16x8 a0[4], a1[4]; };
__device__ __forceinline__ void v_load(VFrag& v, const LAS char* vb) {
#pragma unroll
    for (int s = 0; s < 4; ++s) { v.a0[s] = *(const LAS bf16x8*)(vb + 32 * s); v.a1[s] = *(const LAS bf16x8*)(vb + 32 * ROWB + 32 * s); }
}
__device__ __forceinline__ void pv_mma(f32x16& o0, f32x16& o1, const VFrag& v, const f32x16& p0, const f32x16& p1) {
    bf16x8 pf[4];
#pragma unroll
    for (int s = 0; s < 4; ++s) { v4u w;
        if (s < 2) { const int b = 8 * s; w.x = cvtpk(p0[b], p0[b + 1]); w.y = cvtpk(p0[b + 2], p0[b + 3]); w.z = cvtpk(p0[b + 4], p0[b + 5]); w.w = cvtpk(p0[b + 6], p0[b + 7]); }
        else { const int b = 8 * (s - 2); w.x = cvtpk(p1[b], p1[b + 1]); w.y = cvtpk(p1[b + 2], p1[b + 3]); w.z = cvtpk(p1[b + 4], p1[b + 5]); w.w = cvtpk(p1[b + 6], p1[b + 7]); }
        pf[s] = __builtin_bit_cast(bf16x8, w); }
#pragma unroll
    for (int s = 0; s < 4; ++s) { o0 = __builtin_amdgcn_mfma_f32_32x32x16_bf16(v.a0[s], pf[s], o0, 0, 0, 0); o1 = __builtin_amdgcn_mfma_f32_32x32x16_bf16(v.a1[s], pf[s], o1, 0, 0, 0); }
}
__device__ __forceinline__ void pv_tile(f32x16& o0, f32x16& o1, const LAS char* vb, const f32x16& p0, const f32x16& p1) { VFrag v; v_load(v, vb); pv_mma(o0, o1, v, p0, p1); }
__device__ __forceinline__ float max3f(float a, float b, float c) { float r; asm("v_max3_f32 %0, %1, %2, %3" : "=v"(r) : "v"(a), "v"(b), "v"(c)); return r; }
template <bool WITH_O> __device__ __forceinline__ void softmax_update(f32x16& p0, f32x16& p1, float& m, float& l, f32x16& o0, f32x16& o1, bool active = true) {
    float mx = max3f(p0[0], p1[0], p0[1]);
    mx = max3f(mx, p1[1], p0[2]); mx = max3f(mx, p1[2], p0[3]); mx = max3f(mx, p1[3], p0[4]); mx = max3f(mx, p1[4], p0[5]); mx = max3f(mx, p1[5], p0[6]); mx = max3f(mx, p1[6], p0[7]);
    mx = max3f(mx, p1[7], p0[8]); mx = max3f(mx, p1[8], p0[9]); mx = max3f(mx, p1[9], p0[10]); mx = max3f(mx, p1[10], p0[11]); mx = max3f(mx, p1[11], p0[12]); mx = max3f(mx, p1[12], p0[13]);
    mx = max3f(mx, p1[13], p0[14]); mx = max3f(mx, p1[14], p0[15]); mx = fmaxf(mx, p1[15]);
    mx = active ? hmax(mx) * C2 : -INFINITY;
    const float mnew = fmaxf(m, mx), msafe = (mnew == -INFINITY) ? 0.f : mnew;
    const float alpha = __builtin_amdgcn_exp2f(m - msafe);
    const float negm = active ? -msafe : -INFINITY;
    float sum = 0.f;
#pragma unroll
    for (int r = 0; r < 16; ++r) { p0[r] = __builtin_amdgcn_exp2f(__builtin_fmaf(p0[r], C2, negm)); p1[r] = __builtin_amdgcn_exp2f(__builtin_fmaf(p1[r], C2, negm)); sum += p0[r] + p1[r]; }
    l = l * alpha + sum; m = mnew;
    if (WITH_O) { if (__any(alpha != 1.0f)) {
#pragma unroll
        for (int r = 0; r < 16; ++r) { o0[r] *= alpha; o1[r] *= alpha; } } }
}
struct Stage { v4u k, v; };
}
#define FA_LOAD_(SET, II, TMAP_, KG_, KTB_, KSO_, VG_, VSO_, BIAS_) do { const int i_ = ((II) < n_steps_) ? (II) : n_steps_ - 1; const int t = __builtin_amdgcn_readfirstlane(TMAP_(i_)); \
        const char* kg_ = (KG_) + (size_t)t * (KTB_); const char* vg_ = (VG_) + (size_t)t * 128; asm volatile("" : "+s"(kg_), "+s"(vg_)); \
        k##SET = *(const GAS v4u*)((const GAS char*)kg_ + (size_t)(KSO_)); v##SET = *(const GAS v4u*)((const GAS char*)vg_ + (size_t)(VSO_)); b##SET = (BIAS_); } while (0)
#define FA_COMMIT_(SET, BUF, BFIN_) do { *(LAS v4u*)(L + fa::OFF_K + (BUF) * fa::TILEB + sdst) = k##SET; *(LAS v4u*)(L + fa::OFF_V + (BUF) * fa::TILEB + sdst) = v##SET; \
        if (tid < 64) { const float x = b##SET; ((LAS float*)(L + fa::OFF_B))[(BUF) * 64 + tid] = (BFIN_); } } while (0)
#define FA_BAR_() do { asm volatile("s_waitcnt lgkmcnt(0)" ::: "memory"); __builtin_amdgcn_s_barrier(); asm volatile("" ::: "memory"); } while (0)
#define FA_LOOP2(NSTEPS, TMAP, KG, KTILEB, KSO, VG, VSO, BIAS_EXPR, BIAS_FIN, EXIT_EXPR, ...) do { \
    const int n_steps_ = (NSTEPS); \
    v4u k0_, v0_, k1_, v1_; float b0_, b1_; \
    FA_LOAD_(0_, 0, TMAP, KG, KTILEB, KSO, VG, VSO, BIAS_EXPR); FA_COMMIT_(0_, 0, BIAS_FIN); \
    FA_LOAD_(1_, 1, TMAP, KG, KTILEB, KSO, VG, VSO, BIAS_EXPR); \
    FA_BAR_(); \
    _Pragma("unroll 1") for (int i2_ = 0; i2_ < n_steps_; i2_ += 2) { \
        { if (EXIT_EXPR) break; \
          FA_LOAD_(0_, i2_ + 2, TMAP, KG, KTILEB, KSO, VG, VSO, BIAS_EXPR); \
          { const int t = TMAP(i2_); const int cb = 0; const LAS char* kb = kb0; const LAS char* vb = vb0; (void)kb; (void)vb; (void)cb; __VA_ARGS__ } \
          if (i2_ + 1 < n_steps_) FA_COMMIT_(1_, 1, BIAS_FIN); \
          FA_BAR_(); } \
        if (i2_ + 1 < n_steps_) { if (EXIT_EXPR) break; \
          FA_LOAD_(1_, i2_ + 3, TMAP, KG, KTILEB, KSO, VG, VSO, BIAS_EXPR); \
          { const int t = TMAP(i2_ + 1); const int cb = 1; const LAS char* kb = kb0 + fa::TILEB; const LAS char* vb = vb0 + fa::TILEB; (void)kb; (void)vb; (void)cb; __VA_ARGS__ } \
          if (i2_ + 2 < n_steps_) FA_COMMIT_(0_, 0, BIAS_FIN); \
          FA_BAR_(); } \
    } FA_BAR_(); } while (0)
#define FA_TMAP_UP_(i) (t_lo_up_ + (i))
#define FA_LOOP(T_LO, T_HI, KG, KTILEB, KSO, VG, VSO, BIAS_EXPR, BIAS_FIN, ...) do { const int t_lo_up_ = (T_LO); FA_LOOP2((T_HI) - t_lo_up_ + 1, FA_TMAP_UP_, KG, KTILEB, KSO, VG, VSO, BIAS_EXPR, BIAS_FIN, false, __VA_ARGS__); } while (0)
#define CR(r) (((r) & 3) + 8 * ((r) >> 2))

#define FOX_THR 26.0f
__device__ __forceinline__ void fox_unit(LAS unsigned char* lds, unsigned char* ws, int L_, int b, int h, int qb, int tid, int wave, int lane) {
    using fa::bf16x8; using fa::f32x16;
    const int r32 = lane & 31, hi = lane >> 5;
    const int q0 = qb * 256, qw = q0 + 32 * wave;
    const size_t mrow = (size_t)b * T;
    const char* Qg = (const char*)(ws + B_FOX) + (mrow + qw) * 3072 + h * 128;
    const char* Kg = (const char*)(ws + B_FOX) + mrow * 3072 + 1024 + h * 128;
    const char* Vg = (const char*)(ws + B_FVT) + (size_t)(b * 8 + h) * 64 * T * 2;
    const float* cu = (const float*)(ws + WS_CUM) + (size_t)(b * 8 + h) * T;
    bf16x8 qr[4]; float qn2 = 0.f;
_Pragma("unroll")
    for (int d0 = 0; d0 < 4; ++d0) { const v4u w = *(const v4u*)(Qg + (size_t)(unsigned)(r32 * 3072 + d0 * 32 + hi * 16)); qr[d0] = __builtin_bit_cast(bf16x8, w);
        qn2 += blo(w.x) * blo(w.x) + bhi(w.x) * bhi(w.x) + blo(w.y) * blo(w.y) + bhi(w.y) * bhi(w.y) + blo(w.z) * blo(w.z) + bhi(w.z) * bhi(w.z) + blo(w.w) * blo(w.w) + bhi(w.w) * bhi(w.w); }
    const float kmax = sqrtf(__uint_as_float(((const unsigned*)(ws + WS_CTL))[CW_KMAX + 32 * L_ + b * 8 + h]));
    const float qk_ub = sqrtf(half_sum(qn2)) * kmax * 1.001f;
    const int srow = tid >> 3, sch = tid & 7;
    const unsigned kso = (unsigned)(srow * 3072 + sch * 16), vso = (unsigned)(srow * (T * 2) + sch * 16), sdst = (unsigned)(srow * fa::ROWB + sch * 16);
    const float cref = cu[q0];
    LAS char* L = (LAS char*)lds;
    const LAS char* kb0 = L + fa::OFF_K + r32 * fa::ROWB + hi * 16; const LAS char* vb0 = L + fa::OFF_V + r32 * fa::ROWB + hi * 16;
    LAS unsigned* done_f = (LAS unsigned*)(L + fa::OFF_W);
    if (tid < 16) done_f[tid] = 0u;
    float m = -INFINITY, l = 0.f; f32x16 o0, o1;
_Pragma("unroll")
    for (int r = 0; r < 16; ++r) { o0[r] = 0.f; o1[r] = 0.f; }
    const int NT = 4 * qb + 4;
    int step_ = 0;
#define FOX_TMAP_(i) (NT - 1 - (i))
    FA_LOOP2(NT, FOX_TMAP_, Kg, 64 * 3072, kso, Vg, vso, cu[t * 64 + (tid & 63)], 8.0f * (cref - x),
        (step_ > 0 && __builtin_amdgcn_readfirstlane((int)(done_f[((step_ - 1) & 1) * 8 + 0] & done_f[((step_ - 1) & 1) * 8 + 1] & done_f[((step_ - 1) & 1) * 8 + 2] & done_f[((step_ - 1) & 1) * 8 + 3] &
                        done_f[((step_ - 1) & 1) * 8 + 4] & done_f[((step_ - 1) & 1) * 8 + 5] & done_f[((step_ - 1) & 1) * 8 + 6] & done_f[((step_ - 1) & 1) * 8 + 7])) != 0), {
        bool mydone = false;
        if (64 * t <= qw + 31) {
            const LAS float* bl = (const LAS float*)(L + fa::OFF_B) + cb * 64;
            const float ub2 = (qk_ub + bl[63]) * fa::C2;
            mydone = __all(ub2 < m - FOX_THR);
            if (!mydone) {
                f32x16 c0, c1; const LAS float* blh = bl + 4 * hi;
_Pragma("unroll")
                for (int k4 = 0; k4 < 4; ++k4) { const f32x4 x = *(const LAS f32x4*)(blh + 8 * k4), y = *(const LAS f32x4*)(blh + 32 + 8 * k4);
                    c0[4 * k4] = x.x; c0[4 * k4 + 1] = x.y; c0[4 * k4 + 2] = x.z; c0[4 * k4 + 3] = x.w; c1[4 * k4] = y.x; c1[4 * k4 + 1] = y.y; c1[4 * k4 + 2] = y.z; c1[4 * k4 + 3] = y.w; }
                f32x16 p0, p1; fa::qk_tile(p0, p1, kb, qr, c0, c1); fa::VFrag vf; fa::v_load(vf, vb);
                if (64 * t + 63 > qw) { int qq = qw + r32 - 64 * t - 4 * hi; asm volatile("" : "+v"(qq));
_Pragma("unroll")
                    for (int r = 0; r < 16; ++r) { if (CR(r) > qq) p0[r] = -INFINITY; if (CR(r) + 32 > qq) p1[r] = -INFINITY; } }
                fa::softmax_update<true>(p0, p1, m, l, o0, o1);
                fa::pv_mma(o0, o1, vf, p0, p1);
            }
        }
        if (lane == 0) done_f[(step_ & 1) * 8 + wave] = mydone ? 1u : 0u;
        ++step_;
    });
#undef FOX_TMAP_
    const float inv = 1.0f / half_sum(l);
    char* Og = (char*)(ws + B_OATT) + ((size_t)2 * M + mrow + qw + r32) * 1024 + (h * 64) * 2;
_Pragma("unroll")
    for (int k4 = 0; k4 < 4; ++k4) {
        *(v2u*)(Og + (8 * k4 + 4 * hi) * 2) = (v2u){fa::cvtpk(o0[4 * k4] * inv, o0[4 * k4 + 1] * inv), fa::cvtpk(o0[4 * k4 + 2] * inv, o0[4 * k4 + 3] * inv)};
        *(v2u*)(Og + (32 + 8 * k4 + 4 * hi) * 2) = (v2u){fa::cvtpk(o1[4 * k4] * inv, o1[4 * k4 + 1] * inv), fa::cvtpk(o1[4 * k4 + 2] * inv, o1[4 * k4 + 3] * inv)};
    }
}

__device__ __forceinline__ void nsa_unit(LAS unsigned char* lds, unsigned char* ws, int b, int g, int qblk, int tid, int wave, int lane) {
    using fa::bf16x8; using fa::f32x16;
    const int r32 = lane & 31, hi = lane >> 5, qi = r32 & 7, hd = r32 >> 3;
    const int q0 = 64 * qblk, cur = qblk, bg = b * 2 + g;
    const int q = q0 + 8 * wave + qi;
    const size_t mrow = (size_t)b * T;
    const char* Qg = (const char*)(ws + B_NQ) + (mrow + q) * 1024 + ((g * 4 + hd) * 64) * 2;
    bf16x8 qr[4];
_Pragma("unroll")
    for (int d0 = 0; d0 < 4; ++d0) qr[d0] = *(const bf16x8*)(Qg + d0 * 32 + hi * 16);
    const float* gl = (const float*)(ws + WS_SMALL) + (mrow + q) * 32 + g * 4 + hd;
    const float g0 = pg8::sigmoidf_(gl[0]), g1 = pg8::sigmoidf_(gl[8]), g2 = pg8::sigmoidf_(gl[16]);
    const int srow = tid >> 3, sch = tid & 7;
    const unsigned sdst = (unsigned)(srow * fa::ROWB + sch * 16);
    LAS char* L = (LAS char*)lds;
    const LAS char* kb0 = L + fa::OFF_K + r32 * fa::ROWB + hi * 16; const LAS char* vb0 = L + fa::OFF_V + r32 * fa::ROWB + hi * 16;
    LAS float* imp = (LAS float*)(L + fa::OFF_W + wave * fa::WAVEB); LAS unsigned* selm = (LAS unsigned*)(imp + 8 * 132);
    for (int i = lane; i < 8 * 132; i += 64) imp[i] = 0.f;
    f32x16 zc;
_Pragma("unroll")
    for (int r = 0; r < 16; ++r) zc[r] = 0.f;
    f32x16 ot0 = zc, ot1 = zc;
    {
        const char* Kc = (const char*)(ws + WS_CC) + (size_t)bg * 512 * 128; const char* Vc = (const char*)(ws + WS_CCVT) + (size_t)bg * 64 * 1024;
        const unsigned kso = (unsigned)(srow * 128 + sch * 16), vso = (unsigned)(srow * 1024 + sch * 16);
        const int ntc = ((4 * cur + 2) >> 6);
        const int nq = (q >= 31) ? ((q - 31) >> 4) : -1;
        float m1 = -INFINITY, l1 = 0.f; f32x16 o0 = zc, o1 = zc;
        FA_LOOP(0, ntc, Kc, 64 * 128, kso, Vc, vso, 0.f, 0.f * x, {
            f32x16 p0, p1; fa::qk_tile(p0, p1, kb, qr, zc, zc); fa::VFrag vf; fa::v_load(vf, vb);
            int nn = nq - 64 * t - 4 * hi; asm volatile("" : "+v"(nn));
_Pragma("unroll")
            for (int r = 0; r < 16; ++r) { if (CR(r) > nn) p0[r] = -INFINITY; if (CR(r) + 32 > nn) p1[r] = -INFINITY; }
            fa::softmax_update<false>(p0, p1, m1, l1, o0, o1);
        });
        const float lt = half_sum(l1); const float invl = (lt > 0.f) ? 1.0f / lt : 0.f; const float msafe = (m1 == -INFINITY) ? 0.f : m1;
        FA_LOOP(0, ntc, Kc, 64 * 128, kso, Vc, vso, 0.f, 0.f * x, {
            f32x16 p0, p1; fa::qk_tile(p0, p1, kb, qr, zc, zc); fa::VFrag vf; fa::v_load(vf, vb);
            int nn = nq - 64 * t - 4 * hi; asm volatile("" : "+v"(nn));
_Pragma("unroll")
            for (int r = 0; r < 16; ++r) {
                p0[r] = (CR(r) > nn) ? 0.f : __builtin_amdgcn_exp2f(__builtin_fmaf(p0[r], fa::C2, -msafe)) * invl;
                p1[r] = (CR(r) + 32 > nn) ? 0.f : __builtin_amdgcn_exp2f(__builtin_fmaf(p1[r], fa::C2, -msafe)) * invl; }
_Pragma("unroll")
            for (int k4 = 0; k4 < 8; ++k4) {
                float gs, p3;
                if (k4 < 4) { gs = (p0[4 * k4] + p0[4 * k4 + 1]) + (p0[4 * k4 + 2] + p0[4 * k4 + 3]); p3 = p0[4 * k4 + 3]; }
                else { gs = (p1[4 * k4 - 16] + p1[4 * k4 - 15]) + (p1[4 * k4 - 14] + p1[4 * k4 - 13]); p3 = p1[4 * k4 - 13]; }
                gs += dpp_f<0x128>(gs); p3 += dpp_f<0x128>(p3);
                { auto r_ = __builtin_amdgcn_permlane16_swap(__float_as_uint(gs), __float_as_uint(gs), false, false); gs = __uint_as_float(r_[0]) + __uint_as_float(r_[1]); }
                { auto r_ = __builtin_amdgcn_permlane16_swap(__float_as_uint(p3), __float_as_uint(p3), false, false); p3 = __uint_as_float(r_[0]) + __uint_as_float(r_[1]); }
                const int j = 16 * t + ((k4 < 4) ? 2 * k4 : 8 + 2 * (k4 - 4)) + hi;
                if (hd == 0) { atomicAdd((float*)(imp + qi * 132 + j), gs); atomicAdd((float*)(imp + qi * 132 + j + 1), p3); }
            }
            fa::pv_mma(o0, o1, vf, p0, p1);
        });
_Pragma("unroll")
        for (int r = 0; r < 16; ++r) { ot0[r] = g0 * o0[r]; ot1[r] = g0 * o1[r]; }
    }
    WAVE_SYNC();
    {
        const int j0 = lane, j1 = lane + 64;
_Pragma("unroll 1")
        for (int q4 = 0; q4 < 8; q4 += 4) {
            unsigned key0[4], key1[4], Tk[4];
_Pragma("unroll")
            for (int i = 0; i < 4; ++i) { const int qq = q4 + i;
                const float s0 = (j0 == 0 || j0 == cur || j0 == cur - 1) ? 1e4f : imp[qq * 132 + j0], s1 = (j1 == cur || j1 == cur - 1) ? 1e4f : imp[qq * 132 + j1];
                key0[i] = (j0 <= cur) ? __float_as_uint(s0) + 1u : 0u; key1[i] = (j1 <= cur) ? __float_as_uint(s1) + 1u : 0u; Tk[i] = 0u; }
            if (cur + 1 > 16) {
_Pragma("unroll 1")
                for (int bit = 30; bit >= 0; --bit) {
_Pragma("unroll")
                    for (int i = 0; i < 4; ++i) { const unsigned cand = Tk[i] | (1u << bit);
                        const int c = __builtin_popcountll(__ballot(key0[i] >= cand)) + __builtin_popcountll(__ballot(key1[i] >= cand));
                        if (c >= 16) Tk[i] = cand; } }
            }
_Pragma("unroll")
            for (int i = 0; i < 4; ++i) { const int qq = q4 + i;
                bool sel0 = key0[i] != 0u, sel1 = key1[i] != 0u;
                if (cur + 1 > 16) {
                    const bool gt0 = key0[i] > Tk[i], gt1 = key1[i] > Tk[i], eq0 = key0[i] == Tk[i], eq1 = key1[i] == Tk[i];
                    const int need = 16 - (__builtin_popcountll(__ballot(gt0)) + __builtin_popcountll(__ballot(gt1)));
                    const unsigned long long be0 = __ballot(eq0), be1 = __ballot(eq1);
                    const int rank0 = (int)__builtin_amdgcn_mbcnt_hi((unsigned)(be0 >> 32), __builtin_amdgcn_mbcnt_lo((unsigned)be0, 0u)), rank1 = __builtin_popcountll(be0) + (int)__builtin_amdgcn_mbcnt_hi((unsigned)(be1 >> 32), __builtin_amdgcn_mbcnt_lo((unsigned)be1, 0u));
                    sel0 = gt0 || (eq0 && rank0 < need); sel1 = gt1 || (eq1 && rank1 < need);
                }
                const unsigned long long b0 = __ballot(sel0), b1 = __ballot(sel1);
                if (lane == 0) { selm[qq * 4 + 0] = (unsigned)b0; selm[qq * 4 + 1] = (unsigned)(b0 >> 32); selm[qq * 4 + 2] = (unsigned)b1; selm[qq * 4 + 3] = (unsigned)(b1 >> 32); } }
        }
    }
    WAVE_SYNC();
    {
        const unsigned sm0 = selm[qi * 4 + 0], sm1 = selm[qi * 4 + 1], sm2 = selm[qi * 4 + 2], sm3 = selm[qi * 4 + 3];
        const char* Ks = (const char*)(ws + B_KV) + mrow * 1536 + (256 + g * 64) * 2; const char* Vs = (const char*)(ws + B_SVT) + (size_t)bg * 64 * T * 2;
        const unsigned kso = (unsigned)(srow * 1536 + sch * 16), vso = (unsigned)(srow * (T * 2) + sch * 16);
        float m = -INFINITY, l = 0.f; f32x16 o0 = zc, o1 = zc;
        FA_LOOP(0, cur, Ks, 64 * 1536, kso, Vs, vso, 0.f, 0.f * x, {
            const unsigned wsel = (t < 32) ? sm0 : (t < 64) ? sm1 : (t < 96) ? sm2 : sm3;
            const bool sel = (wsel >> (t & 31)) & 1u;
            if (__any(sel)) {
                f32x16 p0, p1; fa::qk_tile(p0, p1, kb, qr, zc, zc); fa::VFrag vf; fa::v_load(vf, vb);
                if (t == cur) { int qq = q - 64 * t - 4 * hi; asm volatile("" : "+v"(qq));
_Pragma("unroll")
                    for (int r = 0; r < 16; ++r) { if (CR(r) > qq) p0[r] = -INFINITY; if (CR(r) + 32 > qq) p1[r] = -INFINITY; } }
                fa::softmax_update<true>(p0, p1, m, l, o0, o1, sel);
                fa::pv_mma(o0, o1, vf, p0, p1);
            }
        });
        const float sc = g1 / half_sum(l);
_Pragma("unroll")
        for (int r = 0; r < 16; ++r) { ot0[r] += sc * o0[r]; ot1[r] += sc * o1[r]; }
    }
    {
        const char* Kw = (const char*)(ws + B_KV) + mrow * 1536 + (512 + g * 64) * 2; const char* Vw = (const char*)(ws + B_WVT) + (size_t)bg * 64 * T * 2;
        const unsigned kso = (unsigned)(srow * 1536 + sch * 16), vso = (unsigned)(srow * (T * 2) + sch * 16);
        float m = -INFINITY, l = 0.f; f32x16 o0 = zc, o1 = zc;
        const int tlo = (cur >= 8) ? cur - 8 : 0;
        FA_LOOP(tlo, cur, Kw, 64 * 1536, kso, Vw, vso, 0.f, 0.f * x, {
            f32x16 p0, p1; fa::qk_tile(p0, p1, kb, qr, zc, zc); fa::VFrag vf; fa::v_load(vf, vb);
            if (t == cur || t == cur - 8) { int qhi = q - 64 * t - 4 * hi, qlo = q - 511 - 64 * t - 4 * hi; asm volatile("" : "+v"(qhi), "+v"(qlo));
_Pragma("unroll")
                for (int r = 0; r < 16; ++r) { if (CR(r) > qhi || CR(r) < qlo) p0[r] = -INFINITY; if (CR(r) + 32 > qhi || CR(r) + 32 < qlo) p1[r] = -INFINITY; } }
            fa::softmax_update<true>(p0, p1, m, l, o0, o1);
            fa::pv_mma(o0, o1, vf, p0, p1);
        });
        const float sc = g2 / half_sum(l);
_Pragma("unroll")
        for (int r = 0; r < 16; ++r) { ot0[r] += sc * o0[r]; ot1[r] += sc * o1[r]; }
    }
    char* Og = (char*)(ws + B_OATT) + (mrow + q) * 1024 + ((g * 4 + hd) * 64) * 2;
_Pragma("unroll")
    for (int k4 = 0; k4 < 4; ++k4) {
        *(v2u*)(Og + (8 * k4 + 4 * hi) * 2) = (v2u){fa::cvtpk(ot0[4 * k4], ot0[4 * k4 + 1]), fa::cvtpk(ot0[4 * k4 + 2], ot0[4 * k4 + 3])};
        *(v2u*)(Og + (32 + 8 * k4 + 4 * hi) * 2) = (v2u){fa::cvtpk(ot1[4 * k4], ot1[4 * k4 + 1]), fa::cvtpk(ot1[4 * k4 + 2], ot1[4 * k4 + 3])};
    }
}

__device__ __forceinline__ void ret_unit(unsigned char* ws, int bh, int c, int qg, int lane) {
    using fa::bf16x8; using fa::f32x16;
    asm volatile("" : "+v"(lane));
    const int r32 = lane & 31, hi = lane >> 5;
    const int b = bh >> 2, h = bh & 3, n = 32 * qg + r32;
    const float lg2 = log2f(1.0f - exp2f(-5.0f - (float)h));
    const size_t row0 = (size_t)b * T + c * 128;
    const char* Rq = (const char*)(ws + B_RET) + (row0 + n) * 3072 + h * 128 + hi * 16;
    bf16x8 qr[4];
_Pragma("unroll")
    for (int d0 = 0; d0 < 4; ++d0) qr[d0] = *(const bf16x8*)(Rq + d0 * 32);
    f32x16 acc[2][2];
_Pragma("unroll")
    for (int eh = 0; eh < 2; ++eh)
_Pragma("unroll")
        for (int tl = 0; tl < 2; ++tl)
_Pragma("unroll")
            for (int r = 0; r < 16; ++r) acc[eh][tl][r] = 0.f;
    { const char* Kg = (const char*)(ws + B_RET) + row0 * 3072 + (256 + h * 64) * 2 + (size_t)r32 * 3072 + hi * 16;
      const char* Vg = (const char*)(ws + B_RVT) + ((size_t)(bh * 128 + r32) * T + c * 128 + 8 * hi) * 2;
_Pragma("unroll")
      for (int kt = 0; kt < 2; ++kt) {
        if (64 * kt <= 32 * qg + 31) {
            bf16x8 k0[4], k1[4];
_Pragma("unroll")
            for (int d0 = 0; d0 < 4; ++d0) { k0[d0] = *(const bf16x8*)(Kg + (size_t)(64 * kt) * 3072 + d0 * 32); k1[d0] = *(const bf16x8*)(Kg + (size_t)(64 * kt + 32) * 3072 + d0 * 32); }
            f32x16 p0, p1;
_Pragma("unroll")
            for (int r = 0; r < 16; ++r) { p0[r] = 0.f; p1[r] = 0.f; }
_Pragma("unroll")
            for (int d0 = 0; d0 < 4; ++d0) { p0 = __builtin_amdgcn_mfma_f32_32x32x16_bf16(k0[d0], qr[d0], p0, 0, 0, 0); p1 = __builtin_amdgcn_mfma_f32_32x32x16_bf16(k1[d0], qr[d0], p1, 0, 0, 0); }
            int qq = n - 64 * kt - 4 * hi; asm volatile("" : "+v"(qq));
_Pragma("unroll")
            for (int r = 0; r < 16; ++r) { if (CR(r) > qq) p0[r] = 0.f; if (CR(r) + 32 > qq) p1[r] = 0.f; }
            bf16x8 pf[4];
_Pragma("unroll")
            for (int s = 0; s < 4; ++s) { v4u w;
                if (s < 2) { const int b8 = 8 * s; w.x = fa::cvtpk(p0[b8], p0[b8 + 1]); w.y = fa::cvtpk(p0[b8 + 2], p0[b8 + 3]); w.z = fa::cvtpk(p0[b8 + 4], p0[b8 + 5]); w.w = fa::cvtpk(p0[b8 + 6], p0[b8 + 7]); }
                else { const int b8 = 8 * (s - 2); w.x = fa::cvtpk(p1[b8], p1[b8 + 1]); w.y = fa::cvtpk(p1[b8 + 2], p1[b8 + 3]); w.z = fa::cvtpk(p1[b8 + 4], p1[b8 + 5]); w.w = fa::cvtpk(p1[b8 + 6], p1[b8 + 7]); }
                pf[s] = __builtin_bit_cast(bf16x8, w); }
_Pragma("unroll")
            for (int eh = 0; eh < 2; ++eh) {
                bf16x8 v0[4], v1[4];
_Pragma("unroll")
                for (int s = 0; s < 4; ++s) { v0[s] = *(const bf16x8*)(Vg + (size_t)(64 * eh) * T * 2 + (64 * kt + 16 * s) * 2); v1[s] = *(const bf16x8*)(Vg + (size_t)(64 * eh + 32) * T * 2 + (64 * kt + 16 * s) * 2); }
_Pragma("unroll")
                for (int s = 0; s < 4; ++s) { acc[eh][0] = __builtin_amdgcn_mfma_f32_32x32x16_bf16(v0[s], pf[s], acc[eh][0], 0, 0, 0); acc[eh][1] = __builtin_amdgcn_mfma_f32_32x32x16_bf16(v1[s], pf[s], acc[eh][1], 0, 0, 0); }
            }
        }
      }
    }
    { const float g128 = exp2f(-128.0f * lg2);
_Pragma("unroll")
      for (int eh = 0; eh < 2; ++eh)
_Pragma("unroll")
          for (int tl = 0; tl < 2; ++tl)
_Pragma("unroll")
              for (int r = 0; r < 16; ++r) acc[eh][tl][r] *= g128; }
    { const char* sp = (const char*)(ws + B_RS) + ((size_t)(bh * 64 + c) * 8192 + (size_t)r32 * 64 + 8 * hi) * 2;
_Pragma("unroll")
      for (int eh = 0; eh < 2; ++eh) {
          bf16x8 a0[4], a1[4];
_Pragma("unroll")
          for (int d0 = 0; d0 < 4; ++d0) { a0[d0] = *(const bf16x8*)(sp + (size_t)(64 * eh) * 128 + d0 * 32); a1[d0] = *(const bf16x8*)(sp + (size_t)(64 * eh + 32) * 128 + d0 * 32); }
_Pragma("unroll")
          for (int d0 = 0; d0 < 4; ++d0) { acc[eh][0] = __builtin_amdgcn_mfma_f32_32x32x16_bf16(a0[d0], qr[d0], acc[eh][0], 0, 0, 0); acc[eh][1] = __builtin_amdgcn_mfma_f32_32x32x16_bf16(a1[d0], qr[d0], acc[eh][1], 0, 0, 0); }
      } }
    { const float qd = exp2f((float)(n + 1) * lg2);
_Pragma("unroll")
      for (int eh = 0; eh < 2; ++eh)
_Pragma("unroll")
          for (int tl = 0; tl < 2; ++tl)
_Pragma("unroll")
              for (int r = 0; r < 16; ++r) acc[eh][tl][r] *= qd; }
    float s1 = 0.f;
_Pragma("unroll")
    for (int eh = 0; eh < 2; ++eh)
_Pragma("unroll")
        for (int tl = 0; tl < 2; ++tl)
_Pragma("unroll")
            for (int r = 0; r < 16; ++r) s1 += acc[eh][tl][r];
    const float mean = half_sum(s1) * (1.0f / 128.0f);
    float s2 = 0.f;
_Pragma("unroll")
    for (int eh = 0; eh < 2; ++eh)
_Pragma("unroll")
        for (int tl = 0; tl < 2; ++tl)
_Pragma("unroll")
            for (int r = 0; r < 16; ++r) { const float d = acc[eh][tl][r] - mean; s2 += d * d; }
    const float rs = 1.0f / sqrtf(half_sum(s2) * (1.0f / 128.0f) + NORM_EPS);
    const char* Gg = (const char*)(ws + B_RET) + (row0 + n) * 3072 + (1024 + h * 128) * 2;
    char* Og = (char*)(ws + B_OATT) + ((size_t)M + row0 + n) * 1024 + (h * 128) * 2;
_Pragma("unroll")
    for (int eh = 0; eh < 2; ++eh)
_Pragma("unroll")
        for (int tl = 0; tl < 2; ++tl)
_Pragma("unroll")
            for (int k4 = 0; k4 < 4; ++k4) { const int eo = (64 * eh + 32 * tl + 8 * k4 + 4 * hi) * 2;
                const v2u gw = *(const v2u*)(Gg + eo);
                const float y0 = pg8::siluf_(blo(gw.x)) * (acc[eh][tl][4 * k4] - mean) * rs, y1 = pg8::siluf_(bhi(gw.x)) * (acc[eh][tl][4 * k4 + 1] - mean) * rs,
                            y2 = pg8::siluf_(blo(gw.y)) * (acc[eh][tl][4 * k4 + 2] - mean) * rs, y3 = pg8::siluf_(bhi(gw.y)) * (acc[eh][tl][4 * k4 + 3] - mean) * rs;
                *(v2u*)(Og + eo) = (v2u){fa::cvtpk(y0, y1), fa::cvtpk(y2, y3)}; }
}

__global__ void __launch_bounds__(NWAVES * 64, 2) mk_fwd(Ptrs P) {
    extern __shared__ __attribute__((aligned(16))) unsigned char lds_raw[];
    LAS unsigned char* lds = (LAS unsigned char*)lds_raw;
    volatile LAS unsigned* MISC = (volatile LAS unsigned*)(lds + MISC_OFF);
    for (int u = threadIdx.x; u < (LDS_BYTES - LDSCTL_OFF) / 4; u += NWAVES * 64) ((LAS unsigned*)(lds + LDSCTL_OFF))[u] = 0u;
    const int wave_s = __builtin_amdgcn_readfirstlane((int)(threadIdx.x >> 6));
    __syncthreads();
    XcdBarrier bar = xcd_barrier_post((unsigned*)(P.ws + WS_CTL) + CW_BAR, MISC + 8);
#if MK_MULTI
    const int lo = P.ph_lo, hi = P.ph_hi;
#else
    constexpr int lo = 0, hi = 1 << 20;
#endif
    int ph = 0;
#define IN_PH() (lo <= ph && ph < hi)
#define END_PH() do { if (lo <= ph && ph + 1 < hi) { XcdBarrier b2_ = bar; asm volatile("" : "+s"(b2_.bar), "+s"(b2_.x)); b2_.bar = (unsigned*)(GAS unsigned*)b2_.bar; xcd_barrier(b2_); } ++ph; } while (0)
#define PH_LOCALS \
    unsigned ones_ = ~0u; int wave = wave_s; asm volatile("" : "+s"(ones_), "+s"(wave)); \
    const int lane = (int)__builtin_amdgcn_mbcnt_hi(ones_, __builtin_amdgcn_mbcnt_lo(ones_, 0u)); \
    const int tid = wave * 64 + lane; \
    const int G = gridDim.x; const int bx = blockIdx.x; const int vcu = (G % 8 == 0) ? (bx % 8) * (G / 8) + bx / 8 : bx; \
    const int NGW = G * NWAVES; \
    const int gw = vcu * NWAVES + wave; \
    const __attribute__((address_space(4))) Ptrs* kp = (const __attribute__((address_space(4))) Ptrs*)__builtin_amdgcn_kernarg_segment_ptr(); asm volatile("" : "+s"(kp)); \
    unsigned char* const ws = (unsigned char*)(GAS unsigned char*)kp->ws; float* const outp = (float*)(GAS float*)kp->out;     \
    gu32* const ctl = (gu32*)(ws + WS_CTL); \
    LAS float* const wscr = (LAS float*)(lds + wave * 16384); \
    (void)lane; (void)gw; (void)ctl; (void)wscr; (void)outp; (void)NGW; (void)bx;
#define PIN(i) ((const float*)(const GAS float*)kp->in[i])
#define mod ((float*)(ws + WS_MOD))
#define bias1 ((float*)(ws + WS_BIAS1))
#define ropetab ((f32x2*)(ws + WS_ROPE))
#define cum ((float*)(ws + WS_CUM))
#define CC ((bf16*)(ws + WS_CC))
#define HID ((bf16*)(ws + WS_HID))
#define SMALL ((float*)(ws + WS_SMALL))
#define Hb ((bf16*)(ws + WS_H))
#define NQ ((bf16*)(ws + B_NQ))
#define KV ((bf16*)(ws + B_KV))
#define RET ((bf16*)(ws + B_RET))
#define FOX ((bf16*)(ws + B_FOX))
#define MG ((bf16*)(ws + B_MG))
#define OATT ((bf16*)(ws + B_OATT))
#define MERGED ((bf16*)(ws + B_MERGED))
#define CMP ((bf16*)(ws + B_CMP))
#define RL ((float*)(ws + B_RL))
#define RS ((float*)(ws + B_RS))
#define HG ((bf16*)(ws + WS_HG))
#define SW ((float*)(ws + WS_SLOTW))

    if (IN_PH()) { PH_LOCALS
        {
            constexpr int N_WIN = (1024 / 64) * (NPROJ / 64), N_RD = (512 / 64) * (1024 / 64), N_WO = (1024 / 64) * (1024 / 64), N_C1 = (2048 / 64) * (256 / 64);
            constexpr int N_LAYER = N_WIN + 3 * N_RD + N_WO + 2 * N_C1, N_F13 = (1024 / 64) * (2 * DFF / 64), N_F2 = (DFF / 64) * (1024 / 64);
#pragma unroll 1
            for (int rep_ = 0; rep_ < REP_CONV; ++rep_)
#pragma unroll 1
            for (int it = gw; it < 2 * N_LAYER + N_F13 + N_F2; it += NGW) {
                int r = it;
                if (r < 2 * N_LAYER) {
                    const int L = r / N_LAYER; r -= L * N_LAYER;
                    if (r < N_WIN) { transpose_item<1>(PIN(I_WIN) + (size_t)L * D * DIN, nullptr, DIN, 1024, (bf16*)(ws + W_WIN) + (size_t)L * NPROJ * 1024, NPROJ, r, wscr, lane); continue; } r -= N_WIN;
                    if (r < 3 * N_RD) { const int q = r / N_RD; r -= q * N_RD; const float* w = (q == 0 ? PIN(I_RNSA) : q == 1 ? PIN(I_RRET) : PIN(I_RFOX)) + (size_t)L * 512 * 1024;
                        transpose_item<0>(w, nullptr, 1024, 512, (bf16*)(ws + W_READ) + (size_t)(L * 3 + q) * 1024 * 512, 1024, r, wscr, lane); continue; } r -= 3 * N_RD;
                    if (r < N_WO) { transpose_item<0>(PIN(I_WOUT) + (size_t)L * 1024 * 1024, nullptr, 1024, 1024, (bf16*)(ws + W_OUT) + (size_t)L * 1024 * 1024, 1024, r, wscr, lane); continue; } r -= N_WO;
                    const int kv = r / N_C1; r -= kv * N_C1;
                    transpose_item<0>((kv ? PIN(I_CVW1) : PIN(I_CKW1)) + (size_t)L * 2048 * 256, nullptr, 256, 2048, (bf16*)(ws + W_C1) + (size_t)(L * 2 + kv) * 256 * 2048, 256, r, wscr, lane); continue;
                }
                r -= 2 * N_LAYER;
                if (r < N_F13) { transpose_item<2>(PIN(I_FW1), PIN(I_FW3), DFF, 1024, (bf16*)(ws + W_F13), 2 * DFF, r, wscr, lane); continue; } r -= N_F13;
                transpose_item<0>(PIN(I_FW2), nullptr, 1024, DFF, (bf16*)(ws + W_F2), 1024, r, wscr, lane);
            }
        }
        {
            LAS float* red = (LAS float*)(lds + 8 * 16384 - 4096);
            __syncthreads();
            for (int u = vcu; u < 2 * 96; u += G) {
                const int L = u / 96, j0 = (u % 96) * 64;
                const float* aw = PIN(I_ADAW) + (size_t)L * 1024 * 6144 + j0 + lane; const float* c0 = PIN(I_C), * c1 = PIN(I_C) + 1024;
                float s0 = 0.f, s1 = 0.f;
#pragma unroll 16
                for (int k = wave * 128; k < wave * 128 + 128; ++k) { const float w = aw[(size_t)k * 6144]; const float a0 = c0[k], a1 = c1[k];
                    s0 += (a0 / (1.f + __expf(-a0))) * w; s1 += (a1 / (1.f + __expf(-a1))) * w; }
                red[(wave * 2 + 0) * 64 + lane] = s0; red[(wave * 2 + 1) * 64 + lane] = s1;
                __syncthreads();
                if (wave < 2) { float s = 0.f;
#pragma unroll
                    for (int w = 0; w < 8; ++w) s += red[(w * 2 + wave) * 64 + lane];
                    mod[(size_t)(L * 2 + wave) * 6144 + j0 + lane] = s + PIN(I_ADAB)[L * 6144 + j0 + lane]; }
                __syncthreads();
            }
        }
        for (int idx = gw * 64 + lane; idx < T * 32; idx += NGW * 64) {
            const int t = idx >> 5, i = idx & 31;
            const double inv = exp(-((double)i / 32.0) * 9.210340371976184);
            const double ang = (double)t * inv; double sn, cs; sincos(ang, &sn, &cs);
            ropetab[idx] = (f32x2){(float)cs, (float)sn};
        }
        for (int idx = gw; idx < 2 * 2 * 256; idx += NGW) {
            const int Lq = idx >> 9, kv = (idx >> 8) & 1, j = idx & 255;
            const float* pe = PIN(kv ? I_CVPE : I_CKPE) + (size_t)Lq * 2048; const float* w1 = PIN(kv ? I_CVW1 : I_CKW1) + (size_t)Lq * 2048 * 256 + j;
            float s = 0.f;
#pragma unroll 8
            for (int r = lane; r < 2048; r += 64) s += pe[r] * w1[(size_t)r * 256];
            s = wave_sum(s);
            if (lane == 0) bias1[idx] = s;
        }
    }
    END_PH();

#pragma unroll 1
    for (int L = 0; L < 2; ++L) {
        if (IN_PH()) { PH_LOCALS
            const float* gam = PIN(I_NMIX) + L * 1024;
_Pragma("unroll 1") for (int rep_ = 0; rep_ < REP_NORM; ++rep_)
            for (int m = gw; m < M; m += NGW) {
                const int b = m >> 13; const float* sh = (mod + (size_t)L * 2 * 6144) + b * 6144, * sc = sh + 1024;
                f32x4 v[4]; float ss = 0.f;
                if (L == 0) { const GAS f32x4* xr = (const GAS f32x4*)(PIN(I_X) + (size_t)m * D) + lane;
#pragma unroll
                    for (int q = 0; q < 4; ++q) v[q] = xr[64 * q]; }
                else { const GAS v2u* xr = (const GAS v2u*)((const bf16*)(ws + WS_XR) + (size_t)m * D) + lane;
#pragma unroll
                    for (int q = 0; q < 4; ++q) { const v2u w = xr[64 * q]; v[q] = (f32x4){blo(w.x), bhi(w.x), blo(w.y), bhi(w.y)}; } }
#pragma unroll
                for (int q = 0; q < 4; ++q) ss += (v[q].x * v[q].x + v[q].y * v[q].y) + (v[q].z * v[q].z + v[q].w * v[q].w);
                const float rstd = 1.0f / sqrtf(wave_sum(ss) * (1.f / D) + NORM_EPS);
                GAS v2u* o8 = (GAS v2u*)(Hb + (size_t)m * D) + lane;
#pragma unroll
                for (int q = 0; q < 4; ++q) { const int c = 256 * q + 4 * lane; const f32x4 g4 = *(const f32x4*)(gam + c), s4 = *(const f32x4*)(sc + c), h4 = *(const f32x4*)(sh + c);
                    const f32x4 y = v[q] * rstd * g4 * (s4 + 1.0f) + h4; o8[64 * q] = (v2u){pk2(y.x, y.y), pk2(y.z, y.w)}; }
            }
        }
        END_PH();
        if (IN_PH()) { PH_LOCALS
            pg8::Gemm g{Hb, (const bf16*)(ws + W_WIN) + (size_t)L * NPROJ * 1024, 1024, 1024, 1024}; pg8::StaticOrder S; S.init(M, NPROJ, G, bx);
            pg8::EpiProj E{ws, (unsigned)B_NQ, (unsigned)B_KV, (unsigned)B_RET, (unsigned)B_FOX, (unsigned)B_MG, (unsigned)WS_SMALL};
#pragma unroll 1
            for (int rep_ = 0; rep_ < REP_PROJ; ++rep_) pg8::gemm_phase<pg8::EpiProj, pg8::StaticOrder, true>(lds, g, S, E, tid);
        }
        END_PH();
        if (IN_PH()) { PH_LOCALS
            { float km0 = 0.f, km1 = 0.f;
              const int hh = lane >> 3, i0 = (lane & 7) * 4;
#pragma unroll 1
              for (int m = gw; m < M; m += NGW) {
                const int b = m >> 13, t = m & (T - 1);
                const f32x2* cs = ropetab + t * 32;
                f32x2 cv[4];
#pragma unroll
                for (int q = 0; q < 4; ++q) cv[q] = cs[i0 + q];
                bf16* pq = NQ + (size_t)m * 512 + hh * 64 + i0;
                const bool isk = lane < 48; const int which = hh >> 1, gg = hh & 1; const int q48 = lane - 48;
                const bf16* pk = isk ? (KV + (size_t)m * 768 + which * 256 + gg * 64 + i0) : (KV + (size_t)m * 768 + 128 + (q48 >> 3) * 64 + (q48 & 7) * 8);
                const int koff2 = isk ? 32 : 4;
                bf16* pr = RET + (size_t)m * 1536 + hh * 64 + i0;
                const v2u qa = *(const v2u*)pq, qc = *(const v2u*)(pq + 32);
                const v2u ka = *(const v2u*)pk, kc = *(const v2u*)(pk + koff2);
                const v2u ra = *(const v2u*)pr, rc = *(const v2u*)(pr + 32);
                const v4u fw = *(const v4u*)((const char*)(FOX + (size_t)m * 1536 + 512) + (size_t)(unsigned)(lane * 16));
                { const float x1[4] = {blo(qa.x), bhi(qa.x), blo(qa.y), bhi(qa.y)}, x2[4] = {blo(qc.x), bhi(qc.x), blo(qc.y), bhi(qc.y)}; float y1[4], y2[4];
#pragma unroll
                  for (int q = 0; q < 4; ++q) { y1[q] = x1[q] * cv[q].x - x2[q] * cv[q].y; y2[q] = x2[q] * cv[q].x + x1[q] * cv[q].y; }
                  *(v2u*)pq = (v2u){pk2(y1[0], y1[1]), pk2(y1[2], y1[3])}; *(v2u*)(pq + 32) = (v2u){pk2(y2[0], y2[1]), pk2(y2[2], y2[3])}; }
                { const float x1[4] = {blo(ka.x), bhi(ka.x), blo(ka.y), bhi(ka.y)}, x2[4] = {blo(kc.x), bhi(kc.x), blo(kc.y), bhi(kc.y)}; float y1[4], y2[4];
#pragma unroll
                  for (int q = 0; q < 4; ++q) { y1[q] = x1[q] * cv[q].x - x2[q] * cv[q].y; y2[q] = x2[q] * cv[q].x + x1[q] * cv[q].y; }
                  bf16* d = !isk ? (CMP + ((size_t)(4 + b * 2 + (q48 >> 3)) * T + t) * 64 + (q48 & 7) * 8)
                          : (which == 0) ? (CMP + ((size_t)(b * 2 + gg) * T + t) * 64 + i0) : (KV + (size_t)m * 768 + which * 256 + gg * 64 + i0);
                  const v2u o1 = isk ? (v2u){pk2(y1[0], y1[1]), pk2(y1[2], y1[3])} : ka, o2 = isk ? (v2u){pk2(y2[0], y2[1]), pk2(y2[2], y2[3])} : kc;
                  *(v2u*)d = o1; *(v2u*)(d + koff2) = o2; }
                { const float sc8 = (hh >= 4) ? 0.125f : 1.0f;
                  const float x1[4] = {blo(ra.x), bhi(ra.x), blo(ra.y), bhi(ra.y)}, x2[4] = {blo(rc.x), bhi(rc.x), blo(rc.y), bhi(rc.y)}; float y1[4], y2[4];
#pragma unroll
                  for (int q = 0; q < 4; ++q) { y1[q] = (x1[q] * cv[q].x - x2[q] * cv[q].y) * sc8; y2[q] = (x2[q] * cv[q].x + x1[q] * cv[q].y) * sc8; }
                  *(v2u*)pr = (v2u){pk2(y1[0], y1[1]), pk2(y1[2], y1[3])}; *(v2u*)(pr + 32) = (v2u){pk2(y2[0], y2[1]), pk2(y2[2], y2[3])}; }
                { float s = blo(fw.x) * blo(fw.x) + bhi(fw.x) * bhi(fw.x) + blo(fw.y) * blo(fw.y) + bhi(fw.y) * bhi(fw.y) + blo(fw.z) * blo(fw.z) + bhi(fw.z) * bhi(fw.z) + blo(fw.w) * blo(fw.w) + bhi(fw.w) * bhi(fw.w);
                  s += dpp_f<0xB1>(s); s += dpp_f<0x4E>(s); s += dpp_f<0x141>(s);
                  if (m < T) km0 = fmaxf(km0, s); else km1 = fmaxf(km1, s); }
              }
              LAS unsigned* kml = (LAS unsigned*)(lds + MISC_OFF + 192);
              if (tid < 16) kml[tid] = 0u;
              __syncthreads();
              if ((lane & 7) == 0) { atomicMax((unsigned*)(kml + (lane >> 3)), __float_as_uint(km0)); atomicMax((unsigned*)(kml + 8 + (lane >> 3)), __float_as_uint(km1)); }
              __syncthreads();
              if (tid < 16) { const unsigned v = kml[tid]; gu32* gp = ctl + CW_KMAX + 32 * L + tid; if (v > __hip_atomic_load(gp, RLX_AGENT)) atomicMax((unsigned*)gp, v); }
            }
            if (gw == NGW - 1) { unsigned z_ = 0u; asm volatile("" : "+v"(z_)); for (int i = lane; i < 1024 / 8; i += 64) *(v4u*)(CMP + (size_t)8 * T * 64 + i * 8) = (v4u){z_, z_, z_, z_}; }
            if (vcu < 16) {
                __syncthreads();
                const int bh = vcu, b = bh >> 3, h = bh & 7; const float fb = PIN(I_FBIAS)[L * 8 + h];
                const float* srcp = SMALL + ((size_t)b * T + tid * 16) * 32 + 24 + h;
                float ls[16];
#pragma unroll
                for (int i = 0; i < 16; ++i) { const float x = srcp[(size_t)i * 32] + fb; ls[i] = fminf(x, 0.f) - __logf(1.0f + __expf(-fabsf(x))); }
                double tot = 0.0;
#pragma unroll
                for (int i = 0; i < 16; ++i) tot += (double)ls[i];
                LAS double* sd = (LAS double*)lds; sd[tid] = tot;
                __syncthreads();
                double off = 0.0;
                for (int i = 0; i < tid; ++i) off += sd[i];
                float* dst = cum + (size_t)bh * T + tid * 16;
#pragma unroll
                for (int i = 0; i < 16; ++i) { off += (double)ls[i]; dst[i] = (float)off; }
                __syncthreads();
            }
        }
        END_PH();
        if (IN_PH()) { PH_LOCALS
            {
                const int ks = (bx >> 4) & 3;
                pg8::Gemm g{CMP + ks * 512, (const bf16*)(ws + W_C1) + (size_t)L * 2 * 256 * 2048 + ks * 512, 1024, 2048, 512}; pg8::CmpOrder S{G, bx};
                pg8::EpiPart E{(float*)(ws + B_PART) + (size_t)ks * 4096 * 256};
                pg8::gemm_phase<pg8::EpiPart, pg8::CmpOrder, true>(lds, g, S, E, tid);
            }
            { const int r32 = lane & 31, hi = lane >> 5;
              fa::bf16x8 E0, E1;
#pragma unroll
              for (int j = 0; j < 8; ++j) { E0[j] = (r32 == 8 * hi + j) ? (short)0x3F80 : (short)0; E1[j] = (r32 == 16 + 8 * hi + j) ? (short)0x3F80 : (short)0; }
#pragma unroll 1
              for (int u = gw; u < 48 * 128; u += NGW) {
                const int which = u >> 7, tb = u & 127; const bf16* sp; bf16* dp; int pitch = 1536; float lg2 = 0.f;
                if (which < 16) { sp = FOX + ((size_t)(which >> 3) * T + tb * 64) * 1536 + 1024 + (which & 7) * 64; dp = (bf16*)(ws + B_FVT) + (size_t)which * 64 * T; }
                else if (which < 20) { const int bg2 = which - 16; sp = KV + ((size_t)(bg2 >> 1) * T + tb * 64) * 768 + 384 + (bg2 & 1) * 64; dp = (bf16*)(ws + B_SVT) + (size_t)bg2 * 64 * T; pitch = 768; }
                else if (which < 24) { const int bg2 = which - 20; sp = KV + ((size_t)(bg2 >> 1) * T + tb * 64) * 768 + 640 + (bg2 & 1) * 64; dp = (bf16*)(ws + B_WVT) + (size_t)bg2 * 64 * T; pitch = 768; }
                else if (which < 40) { const int j2 = which - 24, bh = j2 >> 1, eh = j2 & 1; sp = RET + ((size_t)(bh >> 2) * T + tb * 64) * 1536 + 512 + (bh & 3) * 128 + eh * 64; dp = (bf16*)(ws + B_RVT) + (size_t)(bh * 128 + eh * 64) * T;
                    lg2 = log2f(1.0f - exp2f(-5.0f - (float)(bh & 3))); }
                else { const int bh = which - 40; sp = RET + ((size_t)(bh >> 2) * T + tb * 64) * 1536 + 256 + (bh & 3) * 64; dp = (bf16*)(ws + B_RKT) + (size_t)bh * 64 * T; }
                const bool dec = (which >= 24 && which < 40); const int tm0 = 127 - (tb & 1) * 64;
                const char* sb = (const char*)sp; asm volatile("" : "+s"(sb));
                const unsigned lo_ = (unsigned)(r32 * pitch * 2 + hi * 16);
                fa::bf16x8 af[2][4];
#pragma unroll
                for (int rt = 0; rt < 2; ++rt)
#pragma unroll
                    for (int c16 = 0; c16 < 4; ++c16) af[rt][c16] = *(const GAS fa::bf16x8*)((const GAS char*)sb + (size_t)(unsigned)(rt * 32 * pitch * 2) + (size_t)lo_ + c16 * 32);
                char* db = (char*)(dp + tb * 64); asm volatile("" : "+s"(db));
                const unsigned so_ = (unsigned)(r32 * T * 2 + hi * 16);
#pragma unroll
                for (int rt = 0; rt < 2; ++rt)
#pragma unroll
                    for (int ct = 0; ct < 2; ++ct) {
                        fa::f32x16 dacc;
#pragma unroll
                        for (int r = 0; r < 16; ++r) dacc[r] = 0.f;
                        dacc = __builtin_amdgcn_mfma_f32_32x32x16_bf16(af[rt][2 * ct], E0, dacc, 0, 0, 0);
                        dacc = __builtin_amdgcn_mfma_f32_32x32x16_bf16(af[rt][2 * ct + 1], E1, dacc, 0, 0, 0);
                        if (dec) {
#pragma unroll
                            for (int r = 0; r < 16; ++r) dacc[r] *= exp2f((float)(tm0 - 32 * rt - CR(r) - 4 * hi) * lg2); }
#pragma unroll
                        for (int g2_ = 0; g2_ < 2; ++g2_) { const int b8 = 8 * g2_;
                            const v4u w = {fa::cvtpk(dacc[b8], dacc[b8 + 1]), fa::cvtpk(dacc[b8 + 2], dacc[b8 + 3]), fa::cvtpk(dacc[b8 + 4], dacc[b8 + 5]), fa::cvtpk(dacc[b8 + 6], dacc[b8 + 7])};
                            *(GAS v4u*)((GAS char*)db + (size_t)(unsigned)(ct * 32 * T * 2) + (size_t)so_ + (32 * rt + 16 * g2_) * 2) = w; }
                    }
              }
            }
        }
        END_PH();
        if (IN_PH()) { PH_LOCALS
            { LAS float* w2s = (LAS float*)lds; LAS float* hs = (LAS float*)(lds + 65536 + wave * 1024);
#pragma unroll 1
              for (int kv = 0; kv < 2; ++kv) {
                __syncthreads();
                { const float* w2 = PIN(kv ? I_CVW2 : I_CKW2) + (size_t)L * 256 * 64;
#pragma unroll
                  for (int i = 0; i < 8; ++i) *(LAS f32x4*)(w2s + (i * 512 + tid) * 4) = *(const f32x4*)(w2 + (i * 512 + tid) * 4); }
                __syncthreads();
                const float* b1 = bias1 + L * 512 + kv * 256 + 4 * lane;
#pragma unroll 1
                for (int r = gw; r < 2048; r += NGW) { const int row = kv * 2048 + r;
                    const float* pp = (const float*)(ws + B_PART) + (size_t)row * 256 + 4 * lane;
                    f32x4 h = *(const f32x4*)b1;
#pragma unroll
                    for (int s4 = 0; s4 < 4; ++s4) h += *(const f32x4*)(pp + (size_t)s4 * 4096 * 256);
                    h.x = pg8::siluf_(h.x); h.y = pg8::siluf_(h.y); h.z = pg8::siluf_(h.z); h.w = pg8::siluf_(h.w);
                    WAVE_SYNC(); *(LAS f32x4*)(hs + 4 * lane) = h; WAVE_SYNC();
                    float s = 0.f;
#pragma unroll 8
                    for (int j = 0; j < 256; j += 4) { const f32x4 hv = *(const LAS f32x4*)(hs + j);
                        s += hv.x * w2s[(j + 0) * 64 + lane] + hv.y * w2s[(j + 1) * 64 + lane] + hv.z * w2s[(j + 2) * 64 + lane] + hv.w * w2s[(j + 3) * 64 + lane]; }
                    if (kv == 0) CC[(size_t)row * 64 + lane] = (bf16)f2bf(s);
                    else { const int bgn = row - 2048, bg2 = bgn >> 9, n = bgn & 511; ((bf16*)(ws + WS_CCVT))[((size_t)bg2 * 64 + lane) * 512 + fa::perm16(n)] = (bf16)f2bf(s); }
                }
              }
              __syncthreads();
            }
            { const int r32 = lane & 31, hi = lane >> 5, et = wave & 3, dt = wave >> 2;
#pragma unroll 1
              for (int u = vcu; u < 512; u += G) { const int bh = u >> 6, c = u & 63;
                const char* va = (const char*)(ws + B_RVT) + ((size_t)(bh * 128 + 32 * et + r32) * T + c * 128 + 8 * hi) * 2;
                const char* kb2 = (const char*)(ws + B_RKT) + ((size_t)(bh * 64 + 32 * dt + r32) * T + c * 128 + 8 * hi) * 2;
                fa::f32x16 acc;
#pragma unroll
                for (int r = 0; r < 16; ++r) acc[r] = 0.f;
                fa::bf16x8 af[8], bf[8];
#pragma unroll
                for (int s = 0; s < 8; ++s) { af[s] = *(const fa::bf16x8*)(va + 32 * s); bf[s] = *(const fa::bf16x8*)(kb2 + 32 * s); }
#pragma unroll
                for (int s = 0; s < 8; ++s) acc = __builtin_amdgcn_mfma_f32_32x32x16_bf16(af[s], bf[s], acc, 0, 0, 0);
                float* dst = RL + (size_t)u * 8192 + (size_t)(32 * et + 4 * hi) * 64 + 32 * dt + r32;
#pragma unroll
                for (int r = 0; r < 16; ++r) dst[(size_t)CR(r) * 64] = acc[r];
              }
            }
        }
        END_PH();
        if (IN_PH()) { PH_LOCALS
#pragma unroll 1
            for (int idx = gw * 64 + lane; idx < 8 * 8192; idx += NGW * 64) {
                const int bh = idx >> 13, ed = idx & 8191, h = bh & 3;
                const float cd = exp2f(128.0f * log2f(1.0f - exp2f(-5.0f - (float)h)));
                float s = 0.f; const float* srcp = RL + (size_t)bh * 64 * 8192 + ed; bf16* dst = (bf16*)(ws + B_RS) + (size_t)bh * 64 * 8192 + ed;
#pragma unroll 16
                for (int c = 0; c < 64; ++c) { dst[(size_t)c * 8192] = (bf16)f2bf(s); s = s * cd + srcp[(size_t)c * 8192]; }
            }
        }
        END_PH();
        if (IN_PH()) {
          { PH_LOCALS
#pragma unroll 1
            for (int rep_ = 0; rep_ < REP_FOX; ++rep_)
#pragma unroll 1
            for (int u2 = 2 * vcu; u2 < 512; u2 += 2 * G) {
#pragma unroll 1
                for (int k = 0; k < 2; ++k) { const int u = u2 >> 1, bh = u >> 4, s = u & 15; fox_unit(lds, ws, L, bh >> 3, bh & 7, k ? s : 31 - s, tid, wave, lane); } }
          }
          { PH_LOCALS
#pragma unroll 1
            for (int rep_ = 0; rep_ < REP_NSA; ++rep_)
#pragma unroll 1
            for (int u2 = 2 * vcu; u2 < 512; u2 += 2 * G) {
#pragma unroll 1
                for (int k = 0; k < 2; ++k) { const int u = u2 >> 1, bg2 = u >> 6, s = u & 63; nsa_unit(lds, ws, bg2 >> 1, bg2 & 1, k ? s : 127 - s, tid, wave, lane); } }
            __syncthreads();
          }
          { PH_LOCALS
#pragma unroll 1
            for (int rep_ = 0; rep_ < REP_RET; ++rep_)
#pragma unroll 1
            for (int u = 2 * vcu + (wave >> 2); u < 512; u += 2 * G) ret_unit(ws, u >> 6, u & 63, wave & 3, lane);
          }
        }
        END_PH();
        if (IN_PH()) { PH_LOCALS
            pg8::MergeOrder S; S.so.init(M, 1024, G, bx);
            pg8::Gemm g{OATT, (const bf16*)(ws + W_READ) + (size_t)L * 3 * 1024 * 512, 512, 512, 512}; pg8::EpiMergeS E{MG, MERGED};
            pg8::gemm_phase<pg8::EpiMergeS, pg8::MergeOrder, true>(lds, g, S, E, tid);
        }
        END_PH();
        if (IN_PH()) { PH_LOCALS
            pg8::Gemm g{MERGED, (const bf16*)(ws + W_OUT) + (size_t)L * 1024 * 1024, 1024, 1024, 1024}; pg8::StaticOrder S; S.init(M, 1024, G, bx);
            bf16* XR = (bf16*)(ws + WS_XR);
            if (L == 0) { pg8::EpiResid<true> E{PIN(I_X), nullptr, XR, (mod + (size_t)L * 2 * 6144) + 2 * 1024, 6144};
                pg8::gemm_phase<pg8::EpiResid<true>, pg8::StaticOrder, true>(lds, g, S, E, tid); }
            else { pg8::EpiResid<false> E{nullptr, XR, XR, (mod + (size_t)L * 2 * 6144) + 2 * 1024, 6144};
                pg8::gemm_phase<pg8::EpiResid<false>, pg8::StaticOrder, true>(lds, g, S, E, tid); }
        }
        END_PH();
        if (IN_PH()) { PH_LOCALS
            const float* gam = PIN(I_NFFN) + L * 1024;
            if (L == 1) { if (tid < 8) ((LAS unsigned*)(lds + MISC_OFF + 128))[tid] = 0u; __syncthreads(); }
            for (int m = gw; m < M; m += NGW) {
                const int b = m >> 13; const float* sh = (mod + (size_t)L * 2 * 6144) + b * 6144 + 3 * 1024, * sc = sh + 1024;
                const GAS v2u* xr = (const GAS v2u*)((const bf16*)(ws + WS_XR) + (size_t)m * D) + lane;
                f32x4 v[4]; float ss = 0.f;
#pragma unroll
                for (int q = 0; q < 4; ++q) { const v2u w = xr[64 * q]; v[q] = (f32x4){blo(w.x), bhi(w.x), blo(w.y), bhi(w.y)}; ss += (v[q].x * v[q].x + v[q].y * v[q].y) + (v[q].z * v[q].z + v[q].w * v[q].w); }
                const float rstd = 1.0f / sqrtf(wave_sum(ss) * (1.f / D) + NORM_EPS);
                GAS v2u* o8 = (GAS v2u*)(Hb + (size_t)m * D) + lane;
                float lg[8] = {};
#pragma unroll
                for (int q = 0; q < 4; ++q) { const int c = 256 * q + 4 * lane; const f32x4 g4 = *(const f32x4*)(gam + c), s4 = *(const f32x4*)(sc + c), h4 = *(const f32x4*)(sh + c);
                    const f32x4 y = v[q] * rstd * g4 * (s4 + 1.0f) + h4; o8[64 * q] = (v2u){pk2(y.x, y.y), pk2(y.z, y.w)};
                    if (L == 1) { const float* rw = PIN(I_ROUTER) + (size_t)c * 8;
#pragma unroll
                        for (int e4 = 0; e4 < 4; ++e4) { const f32x4 w0 = *(const f32x4*)(rw + e4 * 8), w1 = *(const f32x4*)(rw + e4 * 8 + 4); const float yy = y[e4];
                            lg[0] += yy * w0.x; lg[1] += yy * w0.y; lg[2] += yy * w0.z; lg[3] += yy * w0.w; lg[4] += yy * w1.x; lg[5] += yy * w1.y; lg[6] += yy * w1.z; lg[7] += yy * w1.w; } }
                }
                if (L == 1) {
#pragma unroll
                    for (int e = 0; e < 8; ++e) lg[e] = wave_sum(lg[e]);
                    int e0 = 0; float v0 = lg[0];
#pragma unroll
                    for (int e = 1; e < 8; ++e) if (lg[e] > v0) { v0 = lg[e]; e0 = e; }
                    int e1 = -1; float v1 = -INFINITY;
#pragma unroll
                    for (int e = 0; e < 8; ++e) if (e != e0 && lg[e] > v1) { v1 = lg[e]; e1 = e; }
                    const float w1 = 1.0f / (1.0f + __expf(v0 - v1)), w0 = 1.0f - w1;
                    if (lane == 0) {
                        LAS unsigned* lcnt = (LAS unsigned*)(lds + MISC_OFF + 128);
                        const unsigned r0 = atomicAdd((unsigned*)(lcnt + e0), 1u), r1 = atomicAdd((unsigned*)(lcnt + e1), 1u);
                        int* ti = (int*)(ws + WS_TOKINFO) + (size_t)m * 8;
                        ti[0] = e0; ti[1] = (int)r0; ti[2] = e1; ti[3] = (int)r1; ((float*)ti)[4] = w0; ((float*)ti)[5] = w1;
                    }
                }
            }
            if (L == 1) {
                __syncthreads();
                if (tid < 8) { const unsigned n_ = ((LAS unsigned*)(lds + MISC_OFF + 128))[tid];
                    ((int*)(ws + WS_BBASE))[vcu * 8 + tid] = (int)__hip_atomic_fetch_add((unsigned*)(ctl + CW_ECNT + 64 * tid), n_, RLX_AGENT); }
            }
            if (L == 1) {
                const int n13 = tj_items(1024, 2 * DFE), n2 = tj_items(DFE, 1024);
#pragma unroll 1
                for (int rep_ = 0; rep_ < REP_CONV; ++rep_)
#pragma unroll 1
                for (int it = gw; it < NEXP * (n13 + n2); it += NGW) {
                    const int e = it / (n13 + n2); int r = it - e * (n13 + n2);
                    if (r < n13) { transpose_item<2>(PIN(I_MW1) + (size_t)e * D * DFE, PIN(I_MW3) + (size_t)e * D * DFE, DFE, 1024, (bf16*)(ws + B_MW13) + (size_t)e * 2 * DFE * 1024, 2 * DFE, r, wscr, lane); continue; }
                    r -= n13; transpose_item<0>(PIN(I_MW2) + (size_t)e * DFE * D, nullptr, 1024, DFE, (bf16*)(ws + B_MW2) + (size_t)e * 1024 * DFE, 1024, r, wscr, lane);
                }
            }
        }
        END_PH();
        if (L == 0) {
            if (IN_PH()) { PH_LOCALS
                pg8::Gemm g{Hb, (const bf16*)(ws + W_F13), 1024, 1024, 1024}; pg8::StaticOrder S; S.init(M, 2 * DFF, G, bx);
                pg8::EpiSwiglu E{(bf16*)(ws + B_ACT0), DFF, 1 << 20};
                _Pragma("unroll 1") for (int rep_ = 0; rep_ < REP_FFN; ++rep_) pg8::gemm_phase<pg8::EpiSwiglu, pg8::StaticOrder, true>(lds, g, S, E, tid);
            }
            END_PH();
            if (IN_PH()) { PH_LOCALS
                pg8::Gemm g{(const bf16*)(ws + B_ACT0), (const bf16*)(ws + W_F2), DFF, DFF, DFF}; pg8::StaticOrder S; S.init(M, 1024, G, bx);
                bf16* XR = (bf16*)(ws + WS_XR); pg8::EpiResid<false> E{nullptr, XR, XR, (mod + (size_t)L * 2 * 6144) + 5 * 1024, 6144};
                pg8::gemm_phase<pg8::EpiResid<false>, pg8::StaticOrder, true>(lds, g, S, E, tid);
            }
            END_PH();
        } else {
            LAS int* toff = (LAS int*)(lds + MISC_OFF + 64);
            if (IN_PH()) { PH_LOCALS
                if (tid == 0) { int o = 0; for (int e = 0; e < 8; ++e) { toff[e] = o; o += ((int)__hip_atomic_load((unsigned*)(ctl + CW_ECNT + 64 * e), RLX_AGENT) + 255) >> 8; } toff[8] = o; }
                __syncthreads();
                LAS int* sbase = (LAS int*)(lds + MISC_OFF + 256);
                if (tid < 8) sbase[tid] = toff[tid] * 256 + ((const int*)(ws + WS_BBASE))[vcu * 8 + tid];
                __syncthreads();
                v4u tn0, tn1; v4u an, cn;
                { const GAS v4u* tp = (const GAS v4u*)((const int*)(ws + WS_TOKINFO) + (size_t)gw * 8); tn0 = tp[0]; tn1 = tp[1];
                  const GAS v4u* srcp = (const GAS v4u*)(Hb + (size_t)gw * D) + lane; an = srcp[0]; cn = srcp[64]; }
#pragma unroll 1
                for (int m = gw; m < M; m += NGW) {
                    const v4u t0 = tn0, t1 = tn1; const v4u a = an, c = cn;
                    { const int mn = (m + NGW < M) ? m + NGW : m; const GAS v4u* tp = (const GAS v4u*)((const int*)(ws + WS_TOKINFO) + (size_t)mn * 8); tn0 = tp[0]; tn1 = tp[1];
                      const GAS v4u* srcp = (const GAS v4u*)(Hb + (size_t)mn * D) + lane; an = srcp[0]; cn = srcp[64]; }
                    const int s0 = sbase[t0.x] + (int)t0.y, s1 = sbase[t0.z] + (int)t0.w;
                    GAS v4u* d0 = (GAS v4u*)(HG + (size_t)s0 * D) + lane; GAS v4u* d1 = (GAS v4u*)(HG + (size_t)s1 * D) + lane;
                    d0[0] = a; d0[64] = c; d1[0] = a; d1[64] = c;
                    if (lane == 0) { SW[s0] = __uint_as_float(t1.x); SW[s1] = __uint_as_float(t1.y); }
                }
            }
            END_PH();
            if (IN_PH()) { PH_LOCALS
                if (tid == 0) { int o = 0; for (int e = 0; e < 8; ++e) { toff[e] = o; o += ((int)__hip_atomic_load((unsigned*)(ctl + CW_ECNT + 64 * e), RLX_AGENT) + 255) >> 8; } toff[8] = o; }
                __syncthreads();
                pg8::Gemm g{HG, (const bf16*)(ws + B_MW13), 1024, 1024, 1024}; pg8::MoeOrder S{G, vcu, 28, toff[8], toff};
                pg8::EpiSwiglu E{(bf16*)(ws + B_ACT), DFE, 28};
                _Pragma("unroll 1") for (int rep_ = 0; rep_ < REP_FFN; ++rep_) pg8::gemm_phase<pg8::EpiSwiglu, pg8::MoeOrder, true>(lds, g, S, E, tid);
            }
            END_PH();
            if (IN_PH()) { PH_LOCALS
                if (tid == 0) { int o = 0; for (int e = 0; e < 8; ++e) { toff[e] = o; o += ((int)__hip_atomic_load((unsigned*)(ctl + CW_ECNT + 64 * e), RLX_AGENT) + 255) >> 8; } toff[8] = o; }
                __syncthreads();
                pg8::Gemm g{(const bf16*)(ws + B_ACT), (const bf16*)(ws + B_MW2), DFE, DFE, DFE / 2}; pg8::MoeDownOrder S{G, vcu, toff[8], DFE, toff};
                pg8::EpiY E{HG, (bf16*)(ws + B_MW13), SW};
                pg8::gemm_phase<pg8::EpiY, pg8::MoeDownOrder, true>(lds, g, S, E, tid);
            }
            END_PH();
            if (IN_PH()) { PH_LOCALS
                if (tid == 0) { int o = 0; for (int e = 0; e < 8; ++e) { toff[e] = o; o += ((int)__hip_atomic_load((unsigned*)(ctl + CW_ECNT + 64 * e), RLX_AGENT) + 255) >> 8; } toff[8] = o; }
                __syncthreads();
                const float* fn = PIN(I_FNORM);
                LAS int* sbase = (LAS int*)(lds + MISC_OFF + 256);
                if (tid < 8) sbase[tid] = toff[tid] * 256 + ((const int*)(ws + WS_BBASE))[vcu * 8 + tid];
                __syncthreads();
                const bf16* Y1 = (const bf16*)(ws + B_MW13);
                v4u tnn;
                v2u ya[4], yb[4], za[4], zb[4], xw[4];
                { const v4u t0 = *(const GAS v4u*)((const int*)(ws + WS_TOKINFO) + (size_t)gw * 8);
                  const int mn = (gw + NGW < M) ? gw + NGW : gw; tnn = *(const GAS v4u*)((const int*)(ws + WS_TOKINFO) + (size_t)mn * 8);
                  const int s0 = sbase[t0.x] + (int)t0.y, s1 = sbase[t0.z] + (int)t0.w;
#pragma unroll
                  for (int q = 0; q < 4; ++q) { ya[q] = ((const GAS v2u*)(HG + (size_t)s0 * D) + lane)[64 * q]; yb[q] = ((const GAS v2u*)(HG + (size_t)s1 * D) + lane)[64 * q];
                      za[q] = ((const GAS v2u*)(Y1 + (size_t)s0 * D) + lane)[64 * q]; zb[q] = ((const GAS v2u*)(Y1 + (size_t)s1 * D) + lane)[64 * q];
                      xw[q] = ((const GAS v2u*)((const bf16*)(ws + WS_XR) + (size_t)gw * D) + lane)[64 * q]; } }
#pragma unroll 1
                for (int m = gw; m < M; m += NGW) {
                    const int b = m >> 13; const float* g2 = (mod + (size_t)L * 2 * 6144) + b * 6144 + 5 * 1024;
                    GAS f32x4* xr = (GAS f32x4*)(outp + (size_t)m * D) + lane;
                    f32x4 v[4]; float ss = 0.f;
#pragma unroll
                    for (int q = 0; q < 4; ++q) { const int c = 256 * q + 4 * lane; const f32x4 g4 = *(const f32x4*)(g2 + c); const v2u a = ya[q], d = yb[q], a2 = za[q], d2 = zb[q];
                        const f32x4 f = (f32x4){(blo(a.x) + blo(a2.x)) + (blo(d.x) + blo(d2.x)), (bhi(a.x) + bhi(a2.x)) + (bhi(d.x) + bhi(d2.x)), (blo(a.y) + blo(a2.y)) + (blo(d.y) + blo(d2.y)), (bhi(a.y) + bhi(a2.y)) + (bhi(d.y) + bhi(d2.y))};
                        const v2u x2 = xw[q]; v[q] = (f32x4){blo(x2.x), bhi(x2.x), blo(x2.y), bhi(x2.y)} + g4 * f; ss += (v[q].x * v[q].x + v[q].y * v[q].y) + (v[q].z * v[q].z + v[q].w * v[q].w); }
                    { const int mn = (m + NGW < M) ? m + NGW : m; const v4u t0 = tnn;
                      const int mnn = (mn + NGW < M) ? mn + NGW : mn; tnn = *(const GAS v4u*)((const int*)(ws + WS_TOKINFO) + (size_t)mnn * 8);
                      const int s0 = sbase[t0.x] + (int)t0.y, s1 = sbase[t0.z] + (int)t0.w;
#pragma unroll
                      for (int q = 0; q < 4; ++q) { ya[q] = ((const GAS v2u*)(HG + (size_t)s0 * D) + lane)[64 * q]; yb[q] = ((const GAS v2u*)(HG + (size_t)s1 * D) + lane)[64 * q];
                          za[q] = ((const GAS v2u*)(Y1 + (size_t)s0 * D) + lane)[64 * q]; zb[q] = ((const GAS v2u*)(Y1 + (size_t)s1 * D) + lane)[64 * q];
                          xw[q] = ((const GAS v2u*)((const bf16*)(ws + WS_XR) + (size_t)mn * D) + lane)[64 * q]; } }
                    const float rstd = 1.0f / sqrtf(wave_sum(ss) * (1.f / D) + NORM_EPS);
#pragma unroll
                    for (int q = 0; q < 4; ++q) { const int c = 256 * q + 4 * lane; xr[64 * q] = v[q] * rstd * *(const f32x4*)(fn + c); }
                }
            }
            END_PH();
        }
    }
#undef IN_PH
#undef END_PH
}

constexpr int N_PHASES = 1 + 12 + 14;
extern "C" void kernel_launch(void* const* d_in, const int* in_sizes, int n_in, void* d_out, int out_size, void* d_ws, size_t ws_size, hipStream_t stream) {
    static int grid = 0;
    if (grid == 0) {
        if (n_in != 26 || in_sizes[0] != M * D || out_size != M * D || ws_size < WS_NEED) {
            fprintf(stderr, "kernel_launch: unexpected shapes (n_in %d, in0 %d, out %d, ws %zu, need %zu); nothing launched\n", n_in, n_in > 0 ? in_sizes[0] : -1, out_size, ws_size, (size_t)WS_NEED); grid = -1; return; }
        int dev = 0, cus = 0, per_cu = 0;
        if (hipGetDevice(&dev) != hipSuccess || hipDeviceGetAttribute(&cus, hipDeviceAttributeMultiprocessorCount, dev) != hipSuccess) { grid = -1; return; }
        if (hipFuncSetAttribute((const void*)mk_fwd, hipFuncAttributeMaxDynamicSharedMemorySize, LDS_BYTES) != hipSuccess) { fprintf(stderr, "kernel_launch: hipFuncSetAttribute failed\n"); grid = -1; return; }
        if (hipOccupancyMaxActiveBlocksPerMultiprocessor(&per_cu, (const void*)mk_fwd, NWAVES * 64, LDS_BYTES) != hipSuccess || per_cu < 1)
            fprintf(stderr, "kernel_launch: note: occupancy query reports %d workgroups per CU\n", per_cu);
        (void)hipGetLastError();
        grid = cus;
    }
    if (grid < 0) return;
    if (hipMemsetAsync((char*)d_ws + WS_CTL, 0, CTL_ZERO_BYTES, stream) != hipSuccess) return;
    Ptrs p{};
    for (int i = 0; i < 26; ++i) p.in[i] = (const float*)d_in[i];
    p.out = (float*)d_out; p.ws = (unsigned char*)d_ws;
#if MK_MULTI
    for (int k = 0; k < N_PHASES; ++k) { p.ph_lo = k; p.ph_hi = k + 1; hipLaunchKernelGGL(mk_fwd, dim3(grid), dim3(NWAVES * 64), LDS_BYTES, stream, p); }
#else
    p.ph_lo = 0; p.ph_hi = N_PHASES;
    hipLaunchKernelGGL(mk_fwd, dim3(grid), dim3(NWAVES * 64), LDS_BYTES, stream, p);
#endif
}
```

```cpp
#include <hip/hip_runtime.h>
#include <cstdio>
#include <cstdint>

#ifndef REP_CONV
#define REP_CONV 1
#endif
#ifndef REP_RL
#define REP_RL 1
#endif
#ifndef REP_ROPE
#define REP_ROPE 1
#endif
#ifndef REP_SCAN
#define REP_SCAN 1
#endif
#ifndef REP_TR
#define REP_TR 1
#endif
#ifndef REP_FFN
#define REP_FFN 1
#endif
#ifndef REP_MERGE
#define REP_MERGE 1
#endif
#ifndef REP_NORM
#define REP_NORM 1
#endif
#ifndef REP_CMP
#define REP_CMP 1
#endif
#ifndef REP_FOX
#define REP_FOX 1
#endif
#ifndef REP_NSA
#define REP_NSA 1
#endif
#ifndef REP_RET
#define REP_RET 1
#endif
#ifndef REP_PROJ
#define REP_PROJ 1
#endif
#ifndef MK_MULTI
#define MK_MULTI 0
#endif

namespace pg8 {
#define PG8_LAS __attribute__((address_space(3)))
typedef unsigned short bf16_t;
typedef short bf16x8 __attribute__((ext_vector_type(8)));
typedef float f32x4 __attribute__((ext_vector_type(4)));
typedef unsigned u32x4 __attribute__((ext_vector_type(4)));
typedef unsigned u32x2 __attribute__((ext_vector_type(2)));
constexpr int BM = 256, BK = 64, HALF = 128, HTB = HALF * BK * 2, STAGE_BYTES = 8 * HTB, NXCD = 8, WGM = 4;

__host__ __device__ __forceinline__ int lds_byte(int r, int c) { const int st = (r >> 4) * 2 + (c >> 5), rr = r & 15, cc = c & 31, ob = rr * 64 + cc * 2; return st * 1024 + (ob ^ (((ob >> 9) & 1) << 5)); }
__host__ __device__ __forceinline__ void stage_rc(int b, int& R, int& C) { const int st = b / 1024, sb = b % 1024, swz = sb ^ (((sb >> 9) & 1) << 5); R = (st >> 1) * 16 + swz / 64; C = (st & 1) * 32 + (swz % 64) / 2; }
__host__ __device__ __forceinline__ int perm32(int rho) { const int n = rho >> 4, i = rho & 15; return 8 * (i >> 2) + 4 * n + (i & 3); }

struct Unit { int pm, pn, ks; };
struct Gemm { const bf16_t* A; const bf16_t* Bt; int lda, ldb, K; };

struct StaticOrder {
    int nM, nN, nwg, G, c;
    __device__ void init(int M, int N, int G_, int c_) { nM = M / BM; nN = N / BM; nwg = nM * nN; G = G_; c = c_; }
    __device__ bool next(int i, Unit& u) const {
        const long L = (long)i * G + c; if (L >= nwg) return false;
        int wgid = (int)L; { const int q = nwg / NXCD, r = nwg % NXCD, xcd = wgid % NXCD, off = wgid / NXCD; wgid = (xcd < r ? xcd * (q + 1) : r * (q + 1) + (xcd - r) * q) + off; }
        const int nig = WGM * nN, gid = wgid / nig, fm = gid * WGM, gsz = (nM - fm) < WGM ? (nM - fm) : WGM;
        u.pm = fm + ((wgid % nig) % gsz); u.pn = (wgid % nig) / gsz; u.ks = 0; return true;
    }
};
struct CmpOrder {
    int G, c;
    __device__ bool next(int i, Unit& u) const { if (i != 0 || c >= 64) return false; const int L = c & 15; u.pm = L; u.pn = L >> 3; u.ks = 0; return true; }
};
struct MoeOrder {
    int G, c, ncol, ntiles; const PG8_LAS int* toff;
    __device__ bool next(int i, Unit& u) const {
        const int L = i * G + c; if (L >= ntiles * ncol) return false;
        const int rt = L / ncol, pnl = L - rt * ncol; int e = 0;
#pragma unroll
        for (int k = 1; k < 8; ++k) e += (rt >= toff[k]) ? 1 : 0;
        u.pm = rt; u.pn = e * ncol + pnl; u.ks = 0; return true;
    }
};
struct MoeDownFull {
    int G, c, ntiles; const PG8_LAS int* toff;
    __device__ bool next(int i, Unit& u) const {
        const int L = i * G + c; if (L >= ntiles * 4) return false;
        const int rt = L >> 2, pnl = L & 3; int e = 0;
#pragma unroll
        for (int k = 1; k < 8; ++k) e += (rt >= toff[k]) ? 1 : 0;
        u.pm = rt; u.pn = e * 4 + pnl; u.ks = 0; return true;
    }
};
struct MoeDownOrder {
    int G, c, ntiles, ksbytes; const PG8_LAS int* toff;
    __device__ bool next(int i, Unit& u) const {
        const int L = i * G + c; if (L >= ntiles * 8) return false;
        const int rt = L >> 3, sl = (L >> 2) & 1, pnl = L & 3; int e = 0;
#pragma unroll
        for (int k = 1; k < 8; ++k) e += (rt >= toff[k]) ? 1 : 0;
        u.pm = rt; u.pn = e * 4 + pnl; u.ks = sl * ksbytes; return true;
    }
};

struct MoeTailOrder {
    int G, c, rt0, ntail, F, ksbytes; const PG8_LAS int* toff;
    __device__ bool next(int i, Unit& u) const {
        const int L = i * G + c; if (L >= ntail * 4 * F) return false;
        const int pnl = L & 3, q = L >> 2, rq = q / F, sl = q - rq * F, rt = rt0 + rq; int e = 0;
#pragma unroll
        for (int k = 1; k < 8; ++k) e += (rt >= toff[k]) ? 1 : 0;
        u.pm = rt; u.pn = e * 4 + pnl; u.ks = sl * ksbytes; return true;
    }
};

__device__ __forceinline__ unsigned cvt_pk_bf16(float lo, float hi) { unsigned r; asm volatile("v_cvt_pk_bf16_f32 %0, %1, %2" : "=v"(r) : "v"(lo), "v"(hi)); return r; }
__device__ __forceinline__ unsigned cvt_pk_bf16_t(float lo, float hi) { unsigned r; asm volatile("s_nop 0\n\tv_cvt_pk_bf16_f32 %0, %1, %2" : "=v"(r) : "v"(lo), "v"(hi)); return r; }
__device__ __forceinline__ float bflo(unsigned w) { return __uint_as_float(w << 16); }
__device__ __forceinline__ float bfhi(unsigned w) { return __uint_as_float(w & 0xffff0000u); }
__device__ __forceinline__ float sigmoidf_(float x) { return __builtin_amdgcn_rcpf(1.0f + __expf(-x)); }
__device__ __forceinline__ float siluf_(float x) { return x * sigmoidf_(x); }


struct EpiProj {
    static constexpr bool PERM = true;
    unsigned char* wsb; unsigned o_nq, o_kv, o_ret, o_fox, o_mg, o_small;
    __device__ __forceinline__ void operator()(const f32x4 (&acc)[2][2][4][2], const Unit& u, int wr, int wc, int fr, int fq) const {
        const int row0 = u.pm * BM + wr * 64 + fr; const int pn = u.pn;
        if (pn == 29) {
            if (wc == 0) {
#pragma unroll
                for (int ai = 0; ai < 2; ++ai)
#pragma unroll
                    for (int m = 0; m < 4; ++m) { float* p = (float*)(wsb + o_small) + (size_t)(row0 + ai * HALF + m * 16) * 32 + 8 * fq; *(f32x4*)p = acc[ai][0][m][0]; *(f32x4*)(p + 4) = acc[ai][0][m][1]; }
            }
            return;
        }
        unsigned bo; int ldc, colt; bool sig = false;
        if (pn < 2) { bo = o_nq; ldc = 512; colt = pn * 256; }
        else if (pn < 5) { bo = o_kv; ldc = 768; colt = (pn - 2) * 256; }
        else if (pn < 11) { bo = o_ret; ldc = 1536; colt = (pn - 5) * 256; }
        else if (pn < 17) { bo = o_fox; ldc = 1536; colt = (pn - 11) * 256; }
        else { bo = o_mg; ldc = 3072; colt = (pn - 17) * 256; sig = true; }
        bf16_t* base = (bf16_t*)(wsb + bo);
        const int col0 = colt + wc * 32 + 8 * fq;
#pragma unroll
        for (int ai = 0; ai < 2; ++ai)
#pragma unroll
            for (int m = 0; m < 4; ++m) { bf16_t* rowp = base + (size_t)(row0 + ai * HALF + m * 16) * ldc + col0;
#pragma unroll
                for (int bj = 0; bj < 2; ++bj) { f32x4 v0 = acc[ai][bj][m][0], v1 = acc[ai][bj][m][1];
                    if (pn == 11 || pn == 12) { v0 *= 0.125f * 1.4426950408889634f; v1 *= 0.125f * 1.4426950408889634f; }
                    if (sig) {
#pragma unroll
                        for (int e = 0; e < 4; ++e) { v0[e] = sigmoidf_(v0[e]); v1[e] = sigmoidf_(v1[e]); } }
                    u32x4 w; w.x = cvt_pk_bf16_t(v0[0], v0[1]); w.y = cvt_pk_bf16_t(v0[2], v0[3]); w.z = cvt_pk_bf16_t(v1[0], v1[1]); w.w = cvt_pk_bf16_t(v1[2], v1[3]);
                    *(u32x4*)(rowp + bj * HALF) = w; } }
    }
};
struct EpiHid {
    static constexpr bool PERM = true;
    bf16_t* hid; const float* bias1;
    __device__ __forceinline__ void operator()(const f32x4 (&acc)[2][2][4][2], const Unit& u, int wr, int wc, int fr, int fq) const {
        const int row0 = u.pm * BM + wr * 64 + fr; const int col0 = wc * 32 + 8 * fq; const float* bb = bias1 + u.pn * 256;
#pragma unroll
        for (int ai = 0; ai < 2; ++ai)
#pragma unroll
            for (int m = 0; m < 4; ++m) { bf16_t* rowp = hid + (size_t)(row0 + ai * HALF + m * 16) * 256 + col0;
#pragma unroll
                for (int bj = 0; bj < 2; ++bj) { const f32x4 b0 = *(const f32x4*)(bb + col0 + bj * HALF), b1 = *(const f32x4*)(bb + col0 + bj * HALF + 4);
                    f32x4 v0 = acc[ai][bj][m][0] + b0, v1 = acc[ai][bj][m][1] + b1;
#pragma unroll
                    for (int e = 0; e < 4; ++e) { v0[e] = siluf_(v0[e]); v1[e] = siluf_(v1[e]); }
                    u32x4 w; w.x = cvt_pk_bf16(v0[0], v0[1]); w.y = cvt_pk_bf16(v0[2], v0[3]); w.z = cvt_pk_bf16(v1[0], v1[1]); w.w = cvt_pk_bf16(v1[2], v1[3]);
                    *(u32x4*)(rowp + bj * HALF) = w; } }
    }
};
struct EpiPart {
    static constexpr bool PERM = true;
    float* part;
    __device__ __forceinline__ void operator()(const f32x4 (&acc)[2][2][4][2], const Unit& u, int wr, int wc, int fr, int fq) const {
        const int row0 = u.pm * BM + wr * 64 + fr; const int col0 = wc * 32 + 8 * fq;
#pragma unroll
        for (int ai = 0; ai < 2; ++ai)
#pragma unroll
            for (int m = 0; m < 4; ++m) { float* rowp = part + (size_t)(row0 + ai * HALF + m * 16) * 256 + col0;
#pragma unroll
                for (int bj = 0; bj < 2; ++bj) { *(f32x4*)(rowp + bj * HALF) = acc[ai][bj][m][0]; *(f32x4*)(rowp + bj * HALF + 4) = acc[ai][bj][m][1]; } }
    }
};
template <int ACCUM> struct EpiMerge {
    static constexpr bool PERM = true;
    const bf16_t* gate; bf16_t* out;
    __device__ __forceinline__ void operator()(const f32x4 (&acc)[2][2][4][2], const Unit& u, int wr, int wc, int fr, int fq) const {
        const int row0 = u.pm * BM + wr * 64 + fr; const int col0 = u.pn * BM + wc * 32 + 8 * fq;
#pragma unroll
        for (int ai = 0; ai < 2; ++ai)
#pragma unroll
            for (int m = 0; m < 4; ++m) { const size_t row = (size_t)(row0 + ai * HALF + m * 16);
#pragma unroll
                for (int bj = 0; bj < 2; ++bj) { const int col = col0 + bj * HALF;
                    const u32x4 g = *(const u32x4*)(gate + row * 3072 + col);
                    f32x4 v0 = acc[ai][bj][m][0], v1 = acc[ai][bj][m][1];
                    v0[0] *= bflo(g.x); v0[1] *= bfhi(g.x); v0[2] *= bflo(g.y); v0[3] *= bfhi(g.y); v1[0] *= bflo(g.z); v1[1] *= bfhi(g.z); v1[2] *= bflo(g.w); v1[3] *= bfhi(g.w);
                    if (ACCUM) { const u32x4 o = *(const u32x4*)(out + row * 1024 + col);
                        v0[0] += bflo(o.x); v0[1] += bfhi(o.x); v0[2] += bflo(o.y); v0[3] += bfhi(o.y); v1[0] += bflo(o.z); v1[1] += bfhi(o.z); v1[2] += bflo(o.w); v1[3] += bfhi(o.w); }
                    u32x4 w; w.x = cvt_pk_bf16(v0[0], v0[1]); w.y = cvt_pk_bf16(v0[2], v0[3]); w.z = cvt_pk_bf16(v1[0], v1[1]); w.w = cvt_pk_bf16(v1[2], v1[3]);
                    *(u32x4*)(out + row * 1024 + col) = w; } }
    }
};
struct EpiMergeS {
    static constexpr bool PERM = true;
    const bf16_t* gate; bf16_t* out;
    __device__ __forceinline__ void operator()(const f32x4 (&acc)[2][2][4][2], const Unit& u, int wr, int wc, int fr, int fq) const {
        const int seg = u.pm >> 6; const int row0 = (u.pm & 63) * BM + wr * 64 + fr; const int col0 = (u.pn & 3) * BM + wc * 32 + 8 * fq;
#pragma unroll
        for (int ai = 0; ai < 2; ++ai) {
            u32x4 g[4][2], o[4][2];
#pragma unroll
            for (int m = 0; m < 4; ++m) { const size_t row = (size_t)(row0 + ai * HALF + m * 16);
#pragma unroll
                for (int bj = 0; bj < 2; ++bj) { const int col = col0 + bj * HALF; g[m][bj] = *(const u32x4*)(gate + row * 3072 + seg * 1024 + col);
                    if (seg > 0) o[m][bj] = *(const u32x4*)(out + row * 1024 + col); else o[m][bj] = (u32x4){0u, 0u, 0u, 0u}; } }
#pragma unroll
            for (int m = 0; m < 4; ++m) { const size_t row = (size_t)(row0 + ai * HALF + m * 16);
#pragma unroll
                for (int bj = 0; bj < 2; ++bj) { const int col = col0 + bj * HALF; const u32x4 gg = g[m][bj], oo = o[m][bj];
                    f32x4 v0 = acc[ai][bj][m][0], v1 = acc[ai][bj][m][1];
                    v0[0] = v0[0] * bflo(gg.x) + bflo(oo.x); v0[1] = v0[1] * bfhi(gg.x) + bfhi(oo.x); v0[2] = v0[2] * bflo(gg.y) + bflo(oo.y); v0[3] = v0[3] * bfhi(gg.y) + bfhi(oo.y);
                    v1[0] = v1[0] * bflo(gg.z) + bflo(oo.z); v1[1] = v1[1] * bfhi(gg.z) + bfhi(oo.z); v1[2] = v1[2] * bflo(gg.w) + bflo(oo.w); v1[3] = v1[3] * bfhi(gg.w) + bfhi(oo.w);
                    u32x4 w; w.x = cvt_pk_bf16(v0[0], v0[1]); w.y = cvt_pk_bf16(v0[2], v0[3]); w.z = cvt_pk_bf16(v1[0], v1[1]); w.w = cvt_pk_bf16(v1[2], v1[3]);
                    *(u32x4*)(out + row * 1024 + col) = w; } }
        }
    }
};
struct EpiMergeC {
    static constexpr bool PERM = true;
    const bf16_t* gate; bf16_t* out;
    __device__ __forceinline__ static float rat(float a, float b) { return a * __builtin_amdgcn_rcpf(fmaxf(b, 9.094947e-13f)); }
    __device__ __forceinline__ void operator()(f32x4 (&acc)[2][2][4][2], const Unit& u, int wr, int wc, int fr, int fq) const {
        const int seg = u.pm >> 6; const int row0 = (u.pm & 63) * BM + wr * 64 + fr; const int col0 = (u.pn & 3) * BM + wc * 32 + 8 * fq;
        if (seg < 2) {
#pragma unroll
            for (int ai = 0; ai < 2; ++ai) {
                u32x4 g[4][2], h[4][2];
#pragma unroll
                for (int m = 0; m < 4; ++m) { const size_t row = (size_t)(row0 + ai * HALF + m * 16);
#pragma unroll
                    for (int bj = 0; bj < 2; ++bj) { const int col = col0 + bj * HALF; g[m][bj] = *(const u32x4*)(gate + row * 3072 + seg * 1024 + col); h[m][bj] = *(const u32x4*)(gate + row * 3072 + (seg + 1) * 1024 + col); } }
#pragma unroll
                for (int m = 0; m < 4; ++m)
#pragma unroll
                    for (int bj = 0; bj < 2; ++bj) { const u32x4 gg = g[m][bj], hh = h[m][bj]; f32x4& v0 = acc[ai][bj][m][0]; f32x4& v1 = acc[ai][bj][m][1];
                        const float g0_ = (seg == 0) ? bflo(gg.x) : fmaxf(bflo(gg.x), 9.094947e-13f), g1_ = (seg == 0) ? bfhi(gg.x) : fmaxf(bfhi(gg.x), 9.094947e-13f), g2_ = (seg == 0) ? bflo(gg.y) : fmaxf(bflo(gg.y), 9.094947e-13f), g3_ = (seg == 0) ? bfhi(gg.y) : fmaxf(bfhi(gg.y), 9.094947e-13f),
                                    g4_ = (seg == 0) ? bflo(gg.z) : fmaxf(bflo(gg.z), 9.094947e-13f), g5_ = (seg == 0) ? bfhi(gg.z) : fmaxf(bfhi(gg.z), 9.094947e-13f), g6_ = (seg == 0) ? bflo(gg.w) : fmaxf(bflo(gg.w), 9.094947e-13f), g7_ = (seg == 0) ? bfhi(gg.w) : fmaxf(bfhi(gg.w), 9.094947e-13f);
                        v0[0] *= rat(g0_, bflo(hh.x)); v0[1] *= rat(g1_, bfhi(hh.x)); v0[2] *= rat(g2_, bflo(hh.y)); v0[3] *= rat(g3_, bfhi(hh.y));
                        v1[0] *= rat(g4_, bflo(hh.z)); v1[1] *= rat(g5_, bfhi(hh.z)); v1[2] *= rat(g6_, bflo(hh.w)); v1[3] *= rat(g7_, bfhi(hh.w)); }
            }
        } else {
#pragma unroll
            for (int ai = 0; ai < 2; ++ai) {
                u32x4 g[4][2];
#pragma unroll
                for (int m = 0; m < 4; ++m) { const size_t row = (size_t)(row0 + ai * HALF + m * 16);
#pragma unroll
                    for (int bj = 0; bj < 2; ++bj) { const int col = col0 + bj * HALF; g[m][bj] = *(const u32x4*)(gate + row * 3072 + 2 * 1024 + col); } }
#pragma unroll
                for (int m = 0; m < 4; ++m) { const size_t row = (size_t)(row0 + ai * HALF + m * 16);
#pragma unroll
                    for (int bj = 0; bj < 2; ++bj) { const int col = col0 + bj * HALF; const u32x4 gg = g[m][bj]; const f32x4 v0 = acc[ai][bj][m][0], v1 = acc[ai][bj][m][1];
                        const float t_ = 9.094947e-13f;
                        u32x4 w; w.x = cvt_pk_bf16(v0[0] * fmaxf(bflo(gg.x), t_), v0[1] * fmaxf(bfhi(gg.x), t_)); w.y = cvt_pk_bf16(v0[2] * fmaxf(bflo(gg.y), t_), v0[3] * fmaxf(bfhi(gg.y), t_));
                        w.z = cvt_pk_bf16(v1[0] * fmaxf(bflo(gg.z), t_), v1[1] * fmaxf(bfhi(gg.z), t_)); w.w = cvt_pk_bf16(v1[2] * fmaxf(bflo(gg.w), t_), v1[3] * fmaxf(bfhi(gg.w), t_));
                        *(u32x4*)(out + row * 1024 + col) = w; } }
            }
        }
    }
};
struct MergeOrder {
    StaticOrder so;
    __device__ bool next(int i, Unit& u) const { if (i >= 3) return false; if (!so.next(0, u)) return false; u.pm += 64 * i; u.pn += 4 * i; return true; }
};
template <bool IN_F32> struct EpiResid {
    static constexpr bool PERM = true;
    const float* xin32; const bf16_t* xin; bf16_t* xout; const float* gvec; int gstride;
    __device__ __forceinline__ void operator()(const f32x4 (&acc)[2][2][4][2], const Unit& u, int wr, int wc, int fr, int fq) const {
        const int row0 = u.pm * BM + wr * 64 + fr; const int col0 = u.pn * BM + wc * 32 + 8 * fq; const float* gv = gvec + (size_t)(u.pm >> 5) * gstride;
#pragma unroll
        for (int bj = 0; bj < 2; ++bj) { const int col = col0 + bj * HALF; const f32x4 g0 = *(const f32x4*)(gv + col), g1 = *(const f32x4*)(gv + col + 4);
#pragma unroll
            for (int ai = 0; ai < 2; ++ai) {
                f32x4 x0[4], x1[4];
#pragma unroll
                for (int m = 0; m < 4; ++m) { const size_t off = (size_t)(row0 + ai * HALF + m * 16) * 1024 + col;
                    if (IN_F32) { x0[m] = *(const f32x4*)(xin32 + off); x1[m] = *(const f32x4*)(xin32 + off + 4); }
                    else { const u32x4 w = *(const u32x4*)(xin + off); x0[m] = (f32x4){bflo(w.x), bfhi(w.x), bflo(w.y), bfhi(w.y)}; x1[m] = (f32x4){bflo(w.z), bfhi(w.z), bflo(w.w), bfhi(w.w)}; } }
#pragma unroll
                for (int m = 0; m < 4; ++m) { const size_t off = (size_t)(row0 + ai * HALF + m * 16) * 1024 + col;
                    const f32x4 y0 = x0[m] + g0 * acc[ai][bj][m][0], y1 = x1[m] + g1 * acc[ai][bj][m][1];
                    u32x4 w; w.x = cvt_pk_bf16(y0[0], y0[1]); w.y = cvt_pk_bf16(y0[2], y0[3]); w.z = cvt_pk_bf16(y1[0], y1[1]); w.w = cvt_pk_bf16(y1[2], y1[3]);
                    *(u32x4*)(xout + off) = w; } } }
    }
};
struct EpiSwiglu {
    static constexpr bool PERM = true;
    bf16_t* act; int ldc, ncolt;
    __device__ __forceinline__ void operator()(const f32x4 (&acc)[2][2][4][2], const Unit& u, int wr, int wc, int fr, int fq) const {
        const int row0 = u.pm * BM + wr * 64 + fr; const int pnl = u.pn % ncolt; const int col0 = pnl * 128 + wc * 16 + 4 * fq;
#pragma unroll
        for (int ai = 0; ai < 2; ++ai)
#pragma unroll
            for (int m = 0; m < 4; ++m) { bf16_t* rowp = act + (size_t)(row0 + ai * HALF + m * 16) * ldc + col0;
#pragma unroll
                for (int bj = 0; bj < 2; ++bj) { const f32x4 a = acc[ai][bj][m][0], b = acc[ai][bj][m][1]; f32x4 v;
#pragma unroll
                    for (int e = 0; e < 4; ++e) v[e] = siluf_(a[e]) * b[e];
                    u32x2 w; w.x = cvt_pk_bf16(v[0], v[1]); w.y = cvt_pk_bf16(v[2], v[3]); *(u32x2*)(rowp + bj * 64) = w; } }
    }
};
struct EpiYT {
    static constexpr bool PERM = true;
    bf16_t* y; bf16_t* y1; bf16_t* yt; const float* sw; int ksbytes, row_t0, trows;
    __device__ __forceinline__ void operator()(const f32x4 (&acc)[2][2][4][2], const Unit& u, int wr, int wc, int fr, int fq) const {
        const int row0 = u.pm * BM + wr * 64 + fr; const int col0 = (u.pn & 3) * BM + wc * 32 + 8 * fq;
        const int sl = u.ks / ksbytes;
        bf16_t* base = (sl == 0) ? y : (sl == 1) ? y1 : yt + ((long)(sl - 2) * trows - row_t0) * 1024;
#pragma unroll
        for (int ai = 0; ai < 2; ++ai)
#pragma unroll
            for (int m = 0; m < 4; ++m) { const int row = row0 + ai * HALF + m * 16; const float s = sw[row]; bf16_t* rowp = base + (size_t)row * 1024 + col0;
#pragma unroll
                for (int bj = 0; bj < 2; ++bj) { const f32x4 v0 = acc[ai][bj][m][0] * s, v1 = acc[ai][bj][m][1] * s;
                    u32x4 w; w.x = cvt_pk_bf16(v0[0], v0[1]); w.y = cvt_pk_bf16(v0[2], v0[3]); w.z = cvt_pk_bf16(v1[0], v1[1]); w.w = cvt_pk_bf16(v1[2], v1[3]);
                    *(u32x4*)(rowp + bj * HALF) = w; } }
    }
};
struct EpiY {
    static constexpr bool PERM = true;
    bf16_t* y; bf16_t* y1; const float* sw;
    __device__ __forceinline__ void operator()(const f32x4 (&acc)[2][2][4][2], const Unit& u, int wr, int wc, int fr, int fq) const {
        const int row0 = u.pm * BM + wr * 64 + fr; const int col0 = (u.pn & 3) * BM + wc * 32 + 8 * fq;
#pragma unroll
        for (int ai = 0; ai < 2; ++ai)
#pragma unroll
            for (int m = 0; m < 4; ++m) { const int row = row0 + ai * HALF + m * 16; const float s = sw[row]; bf16_t* rowp = (u.ks ? y1 : y) + (size_t)row * 1024 + col0;
#pragma unroll
                for (int bj = 0; bj < 2; ++bj) { const f32x4 v0 = acc[ai][bj][m][0] * s, v1 = acc[ai][bj][m][1] * s;
                    u32x4 w; w.x = cvt_pk_bf16(v0[0], v0[1]); w.y = cvt_pk_bf16(v0[2], v0[3]); w.z = cvt_pk_bf16(v1[0], v1[1]); w.w = cvt_pk_bf16(v1[2], v1[3]);
                    *(u32x4*)(rowp + bj * HALF) = w; } }
    }
};

template <class Epi, class Sched, bool ALIGN_EPI>
__device__ __forceinline__ void gemm_phase(PG8_LAS unsigned char* lds, const Gemm g, const Sched& S, const Epi& E, const int tid) {
    const int wid = __builtin_amdgcn_readfirstlane(tid >> 6), lane = tid & 63, wr = wid >> 2, wc = wid & 3, fr = lane & 15, fq = lane >> 4;
    const int K = g.K, nt = K / BK, lda = g.lda, ldb = g.ldb;
    unsigned voffA[2], voffB[2];
#pragma unroll
    for (int i = 0; i < 2; ++i) { int R, C; stage_rc(tid * 16 + i * 8192, R, C); const int Rb = Epi::PERM ? ((R & ~31) + perm32(R & 31)) : R;
        voffA[i] = (unsigned)(R * lda + C) * 2u; voffB[i] = (unsigned)(Rb * ldb + C) * 2u; }
    const unsigned kstep = (unsigned)(BK * 2);
    const unsigned hstepA = (unsigned)HALF * (unsigned)lda * 2u, tstepA = 2u * hstepA;
    const unsigned hstepB = (unsigned)HALF * (unsigned)ldb * 2u, tstepB = 2u * hstepB;
    const char* const gA = (const char*)g.A; const char* const gB = (const char*)g.Bt;
    const unsigned ldsw = (unsigned)wid * 1024u;
    const int aoff = lds_byte(wr * 64 + fr, fq * 8), boff = lds_byte(wc * 32 + fr, fq * 8);
#define PG8_SA(b, h) (((b) * 2 + (h)) * HTB)
#define PG8_SB(b, h) ((4 + (b) * 2 + (h)) * HTB)
#define PG8_STAGE(bufoff, gbase, soff, voff) do { _Pragma("unroll") for (int _i = 0; _i < 2; ++_i) \
        __builtin_amdgcn_global_load_lds((const unsigned*)((gbase) + (size_t)(unsigned)((voff)[_i] + (unsigned)(soff))), (PG8_LAS unsigned*)(lds + (bufoff) + ldsw + _i * 8192), 16, 0, 0); } while (0)
#define PG8_LDA(dst, b, h) do { _Pragma("unroll") for (int m = 0; m < 4; ++m) _Pragma("unroll") for (int k = 0; k < 2; ++k) dst[m][k] = *(const PG8_LAS bf16x8*)(lds + PG8_SA(b, h) + aoff + m * 2048 + k * 1024); } while (0)
#define PG8_LDB(dst, b, h) do { _Pragma("unroll") for (int n = 0; n < 2; ++n) _Pragma("unroll") for (int k = 0; k < 2; ++k) dst[n][k] = *(const PG8_LAS bf16x8*)(lds + PG8_SB(b, h) + boff + n * 2048 + k * 1024); } while (0)
#define PG8_MMA(ai, bj, At, Bt) do { __builtin_amdgcn_s_setprio(1); _Pragma("unroll") for (int m = 0; m < 4; ++m) _Pragma("unroll") for (int n = 0; n < 2; ++n) _Pragma("unroll") for (int k = 0; k < 2; ++k) \
        acc[ai][bj][m][n] = __builtin_amdgcn_mfma_f32_16x16x32_bf16(Bt[n][k], At[m][k], acc[ai][bj][m][n], 0, 0, 0); __builtin_amdgcn_s_setprio(0); } while (0)
#define PG8_WAIT_V(n) asm volatile("s_waitcnt vmcnt(" #n ")" ::: "memory")
#define PG8_WAIT_L(n) asm volatile("s_waitcnt lgkmcnt(" #n ")" ::: "memory")
#define PG8_BAR __builtin_amdgcn_s_barrier()
#define PG8_SCHED __builtin_amdgcn_sched_barrier(0)
    Unit cur, nxt; int ui = 0;
    if (!S.next(0, cur)) return;
    unsigned cA = (unsigned)cur.pm * tstepA + (unsigned)cur.ks, cB = (unsigned)cur.pn * tstepB + (unsigned)cur.ks;
    PG8_STAGE(PG8_SB(0, 0), gB, cB, voffB); PG8_STAGE(PG8_SB(0, 1), gB, cB + hstepB, voffB); PG8_STAGE(PG8_SA(0, 0), gA, cA, voffA); PG8_STAGE(PG8_SA(0, 1), gA, cA + hstepA, voffA);
    if (wr == 1) PG8_BAR;
    PG8_WAIT_V(2); PG8_BAR;
    PG8_STAGE(PG8_SB(1, 0), gB, cB + kstep, voffB); PG8_STAGE(PG8_SA(1, 0), gA, cA + kstep, voffA); PG8_STAGE(PG8_SB(1, 1), gB, cB + hstepB + kstep, voffB);
    PG8_WAIT_V(6); PG8_BAR;
    for (;;) {
        const bool has_next = S.next(ui + 1, nxt);
        const unsigned nA = has_next ? (unsigned)nxt.pm * tstepA + (unsigned)nxt.ks : cA; const unsigned nB = has_next ? (unsigned)nxt.pn * tstepB + (unsigned)nxt.ks : cB;
        f32x4 acc[2][2][4][2];
        { float z0 = 0.f; asm volatile("" : "+v"(z0));
#pragma unroll
        for (int a = 0; a < 2; ++a)
#pragma unroll
            for (int b = 0; b < 2; ++b)
#pragma unroll
                for (int m = 0; m < 4; ++m)
#pragma unroll
                    for (int n = 0; n < 2; ++n) acc[a][b][m][n] = (f32x4){z0, z0, z0, z0}; }
        for (int t = 0; t < nt; t += 2) {
            bf16x8 At[4][2], B0[2][2], B1[2][2];
            const bool last = (t == nt - 2);
            const unsigned a1 = cA + (unsigned)(t + 1) * kstep;
            const unsigned a2 = last ? nA : cA + (unsigned)(t + 2) * kstep; const unsigned b2 = last ? nB : cB + (unsigned)(t + 2) * kstep;
            const unsigned a3 = a2 + kstep; const unsigned b3 = b2 + kstep;
            PG8_LDB(B0, 0, 0); PG8_LDB(B1, 0, 1); PG8_SCHED; PG8_LDA(At, 0, 0); PG8_STAGE(PG8_SA(1, 1), gA, a1 + hstepA, voffA);
            PG8_WAIT_V(8); PG8_WAIT_L(0); PG8_BAR; PG8_MMA(0, 0, At, B0); PG8_MMA(0, 1, At, B1); PG8_BAR; PG8_SCHED;
            PG8_LDA(At, 0, 1); PG8_STAGE(PG8_SB(0, 0), gB, b2, voffB); PG8_STAGE(PG8_SB(0, 1), gB, b2 + hstepB, voffB); PG8_STAGE(PG8_SA(0, 0), gA, a2, voffA);
            PG8_WAIT_V(8); PG8_WAIT_L(0); PG8_BAR; PG8_MMA(1, 0, At, B0); PG8_MMA(1, 1, At, B1); PG8_BAR; PG8_SCHED;
            PG8_LDB(B0, 1, 0); PG8_LDB(B1, 1, 1); PG8_SCHED; PG8_LDA(At, 1, 0); PG8_STAGE(PG8_SA(0, 1), gA, a2 + hstepA, voffA);
            PG8_WAIT_V(8); PG8_WAIT_L(0); PG8_BAR; PG8_MMA(0, 0, At, B0); PG8_MMA(0, 1, At, B1); PG8_BAR; PG8_SCHED;
            PG8_LDA(At, 1, 1); PG8_STAGE(PG8_SB(1, 0), gB, b3, voffB); PG8_STAGE(PG8_SB(1, 1), gB, b3 + hstepB, voffB); PG8_STAGE(PG8_SA(1, 0), gA, a3, voffA);
            PG8_WAIT_V(8); PG8_WAIT_L(0); PG8_BAR; PG8_MMA(1, 0, At, B0); PG8_MMA(1, 1, At, B1); PG8_BAR; PG8_SCHED;
        }
        if constexpr (ALIGN_EPI) { if (wr == 0) PG8_BAR; }
        E(acc, cur, wr, wc, fr, fq);
        if (!has_next) break;
        cur = nxt; cA = nA; cB = nB; ++ui;
        if constexpr (ALIGN_EPI) { if (wr == 1) PG8_BAR; }
    }
    PG8_WAIT_V(0);
    if constexpr (!ALIGN_EPI) { if (wr == 0) PG8_BAR; }
    PG8_BAR;
#undef PG8_SA
#undef PG8_SB
#undef PG8_STAGE
#undef PG8_LDA
#undef PG8_LDB
#undef PG8_MMA
#undef PG8_WAIT_V
#undef PG8_WAIT_L
#undef PG8_BAR
#undef PG8_SCHED
}
template <class Epi, class Sched, bool ALIGN_EPI>
__device__ __forceinline__ void gemm_phase_chain(PG8_LAS unsigned char* lds, const Gemm g, const Sched& S, const Epi& E, const int tid) {
    const int wid = __builtin_amdgcn_readfirstlane(tid >> 6), lane = tid & 63, wr = wid >> 2, wc = wid & 3, fr = lane & 15, fq = lane >> 4;
    const int K = g.K, nt = K / BK, lda = g.lda, ldb = g.ldb;
    unsigned voffA[2], voffB[2];
#pragma unroll
    for (int i = 0; i < 2; ++i) { int R, C; stage_rc(tid * 16 + i * 8192, R, C); const int Rb = Epi::PERM ? ((R & ~31) + perm32(R & 31)) : R;
        voffA[i] = (unsigned)(R * lda + C) * 2u; voffB[i] = (unsigned)(Rb * ldb + C) * 2u; }
    const unsigned kstep = (unsigned)(BK * 2);
    const unsigned hstepA = (unsigned)HALF * (unsigned)lda * 2u, tstepA = 2u * hstepA;
    const unsigned hstepB = (unsigned)HALF * (unsigned)ldb * 2u, tstepB = 2u * hstepB;
    const char* const gA = (const char*)g.A; const char* const gB = (const char*)g.Bt;
    const unsigned ldsw = (unsigned)wid * 1024u;
    const int aoff = lds_byte(wr * 64 + fr, fq * 8), boff = lds_byte(wc * 32 + fr, fq * 8);
#define PG8_SA(b, h) (((b) * 2 + (h)) * HTB)
#define PG8_SB(b, h) ((4 + (b) * 2 + (h)) * HTB)
#define PG8_STAGE(bufoff, gbase, soff, voff) do { _Pragma("unroll") for (int _i = 0; _i < 2; ++_i) \
        __builtin_amdgcn_global_load_lds((const unsigned*)((gbase) + (size_t)(unsigned)((voff)[_i] + (unsigned)(soff))), (PG8_LAS unsigned*)(lds + (bufoff) + ldsw + _i * 8192), 16, 0, 0); } while (0)
#define PG8_LDA(dst, b, h) do { _Pragma("unroll") for (int m = 0; m < 4; ++m) _Pragma("unroll") for (int k = 0; k < 2; ++k) dst[m][k] = *(const PG8_LAS bf16x8*)(lds + PG8_SA(b, h) + aoff + m * 2048 + k * 1024); } while (0)
#define PG8_LDB(dst, b, h) do { _Pragma("unroll") for (int n = 0; n < 2; ++n) _Pragma("unroll") for (int k = 0; k < 2; ++k) dst[n][k] = *(const PG8_LAS bf16x8*)(lds + PG8_SB(b, h) + boff + n * 2048 + k * 1024); } while (0)
#define PG8_MMA(ai, bj, At, Bt) do { __builtin_amdgcn_s_setprio(1); _Pragma("unroll") for (int m = 0; m < 4; ++m) _Pragma("unroll") for (int n = 0; n < 2; ++n) _Pragma("unroll") for (int k = 0; k < 2; ++k) \
        acc[ai][bj][m][n] = __builtin_amdgcn_mfma_f32_16x16x32_bf16(Bt[n][k], At[m][k], acc[ai][bj][m][n], 0, 0, 0); __builtin_amdgcn_s_setprio(0); } while (0)
#define PG8_WAIT_V(n) asm volatile("s_waitcnt vmcnt(" #n ")" ::: "memory")
#define PG8_WAIT_L(n) asm volatile("s_waitcnt lgkmcnt(" #n ")" ::: "memory")
#define PG8_BAR __builtin_amdgcn_s_barrier()
#define PG8_SCHED __builtin_amdgcn_sched_barrier(0)
    Unit cur, nxt; int ui = 0;
    if (!S.next(0, cur)) return;
    unsigned cA = (unsigned)cur.pm * tstepA + (unsigned)cur.ks, cB = (unsigned)cur.pn * tstepB + (unsigned)cur.ks;
    PG8_STAGE(PG8_SB(0, 0), gB, cB, voffB); PG8_STAGE(PG8_SB(0, 1), gB, cB + hstepB, voffB); PG8_STAGE(PG8_SA(0, 0), gA, cA, voffA); PG8_STAGE(PG8_SA(0, 1), gA, cA + hstepA, voffA);
    if (wr == 1) PG8_BAR;
    PG8_WAIT_V(2); PG8_BAR;
    PG8_STAGE(PG8_SB(1, 0), gB, cB + kstep, voffB); PG8_STAGE(PG8_SA(1, 0), gA, cA + kstep, voffA); PG8_STAGE(PG8_SB(1, 1), gB, cB + hstepB + kstep, voffB);
    PG8_WAIT_V(6); PG8_BAR;
    f32x4 acc[2][2][4][2];
    { float z0 = 0.f; asm volatile("" : "+v"(z0));
#pragma unroll
    for (int a = 0; a < 2; ++a)
#pragma unroll
        for (int b = 0; b < 2; ++b)
#pragma unroll
            for (int m = 0; m < 4; ++m)
#pragma unroll
                for (int n = 0; n < 2; ++n) acc[a][b][m][n] = (f32x4){z0, z0, z0, z0}; }
    for (;;) {
        const bool has_next = S.next(ui + 1, nxt);
        const unsigned nA = has_next ? (unsigned)nxt.pm * tstepA + (unsigned)nxt.ks : cA; const unsigned nB = has_next ? (unsigned)nxt.pn * tstepB + (unsigned)nxt.ks : cB;
        for (int t = 0; t < nt; t += 2) {
            bf16x8 At[4][2], B0[2][2], B1[2][2];
            const bool last = (t == nt - 2);
            const unsigned a1 = cA + (unsigned)(t + 1) * kstep;
            const unsigned a2 = last ? nA : cA + (unsigned)(t + 2) * kstep; const unsigned b2 = last ? nB : cB + (unsigned)(t + 2) * kstep;
            const unsigned a3 = a2 + kstep; const unsigned b3 = b2 + kstep;
            PG8_LDB(B0, 0, 0); PG8_LDB(B1, 0, 1); PG8_SCHED; PG8_LDA(At, 0, 0); PG8_STAGE(PG8_SA(1, 1), gA, a1 + hstepA, voffA);
            PG8_WAIT_V(8); PG8_WAIT_L(0); PG8_BAR; PG8_MMA(0, 0, At, B0); PG8_MMA(0, 1, At, B1); PG8_BAR; PG8_SCHED;
            PG8_LDA(At, 0, 1); PG8_STAGE(PG8_SB(0, 0), gB, b2, voffB); PG8_STAGE(PG8_SB(0, 1), gB, b2 + hstepB, voffB); PG8_STAGE(PG8_SA(0, 0), gA, a2, voffA);
            PG8_WAIT_V(8); PG8_WAIT_L(0); PG8_BAR; PG8_MMA(1, 0, At, B0); PG8_MMA(1, 1, At, B1); PG8_BAR; PG8_SCHED;
            PG8_LDB(B0, 1, 0); PG8_LDB(B1, 1, 1); PG8_SCHED; PG8_LDA(At, 1, 0); PG8_STAGE(PG8_SA(0, 1), gA, a2 + hstepA, voffA);
            PG8_WAIT_V(8); PG8_WAIT_L(0); PG8_BAR; PG8_MMA(0, 0, At, B0); PG8_MMA(0, 1, At, B1); PG8_BAR; PG8_SCHED;
            PG8_LDA(At, 1, 1); PG8_STAGE(PG8_SB(1, 0), gB, b3, voffB); PG8_STAGE(PG8_SB(1, 1), gB, b3 + hstepB, voffB); PG8_STAGE(PG8_SA(1, 0), gA, a3, voffA);
            PG8_WAIT_V(8); PG8_WAIT_L(0); PG8_BAR; PG8_MMA(1, 0, At, B0); PG8_MMA(1, 1, At, B1); PG8_BAR; PG8_SCHED;
        }
        if constexpr (ALIGN_EPI) { if (wr == 0) PG8_BAR; }
        E(acc, cur, wr, wc, fr, fq);
        if (!has_next) break;
        cur = nxt; cA = nA; cB = nB; ++ui;
        if constexpr (ALIGN_EPI) { if (wr == 1) PG8_BAR; }
    }
    PG8_WAIT_V(0);
    if constexpr (!ALIGN_EPI) { if (wr == 0) PG8_BAR; }
    PG8_BAR;
#undef PG8_SA
#undef PG8_SB
#undef PG8_STAGE
#undef PG8_LDA
#undef PG8_LDB
#undef PG8_MMA
#undef PG8_WAIT_V
#undef PG8_WAIT_L
#undef PG8_BAR
#undef PG8_SCHED
}
}

constexpr int NWAVES = 8;
constexpr int T = 8192, D = 1024, M = 16384;
constexpr int DIN = 7456, NPROJ = 7680;
constexpr int DFF = 2816, DFE = 3584, NEXP = 8;
constexpr int MOE_ROWS = 34816;
constexpr float NORM_EPS = 1e-6f;

constexpr size_t MiB = 1u << 20, KiB = 1024;
constexpr size_t WS_CTL = 0, CTL_ZERO_BYTES = 256 * KiB;
constexpr size_t WS_MOD = 1 * MiB;
constexpr size_t WS_BIAS1 = 1 * MiB + 128 * KiB;
constexpr size_t WS_SLOTW = 1 * MiB + 256 * KiB;
constexpr size_t WS_BBASE = 1 * MiB + 512 * KiB;
constexpr size_t WS_ROPE = 2 * MiB;
constexpr size_t WS_CUM = 4 * MiB;
constexpr size_t WS_CC = 5 * MiB;
constexpr size_t WS_CCVT = 5 * MiB + 512 * KiB;
constexpr size_t WS_HID = 6 * MiB;
constexpr size_t WS_TOKINFO = 8 * MiB;
constexpr size_t WS_SMALL = 10 * MiB;
constexpr size_t WS_W = 14 * MiB;
constexpr size_t W_WIN = WS_W;
constexpr size_t W_READ = W_WIN + 30 * MiB;
constexpr size_t W_OUT = W_READ + 6 * MiB;
constexpr size_t W_C1 = W_OUT + 4 * MiB;
constexpr size_t W_F13 = W_C1 + 4 * MiB;
constexpr size_t W_F2 = W_F13 + 11 * MiB;
constexpr size_t WS_HG = WS_W;
constexpr size_t WS_H = WS_W + 68 * MiB;
constexpr size_t WS_BIG = WS_H + 32 * MiB;
constexpr size_t B_NQ = WS_BIG;
constexpr size_t B_KV = B_NQ + 16 * MiB;
constexpr size_t B_RET = B_KV + 24 * MiB;
constexpr size_t B_FOX = B_RET + 48 * MiB;
constexpr size_t B_MG = B_FOX + 48 * MiB;
constexpr size_t B_OATT = B_MG + 96 * MiB;
constexpr size_t B_MERGED = B_OATT + 48 * MiB;
constexpr size_t B_CMP = B_MERGED + 32 * MiB;
constexpr size_t B_RL = B_CMP + 9 * MiB;
constexpr size_t B_RS = B_RL + 16 * MiB;
constexpr size_t B_FVT = B_RS + 16 * MiB;
constexpr size_t B_SVT = B_FVT + 16 * MiB;
constexpr size_t B_WVT = B_SVT + 4 * MiB;
constexpr size_t B_RVT = B_WVT + 4 * MiB;
constexpr size_t B_RKT = B_RVT + 16 * MiB;
constexpr size_t B_PART = B_RKT + 8 * MiB;
constexpr size_t B_MIX_END = B_PART + 16 * MiB;
constexpr size_t B_ACT0 = WS_BIG;
constexpr size_t B_MW13 = WS_BIG;
constexpr size_t B_MW2 = B_MW13 + 112 * MiB;
constexpr size_t B_ACT = B_MW2 + 56 * MiB;
constexpr size_t B_YT = B_MW13 + 72 * MiB;
constexpr size_t B_MOE_END = B_ACT + (size_t)MOE_ROWS * DFE * 2;
constexpr size_t WS_XR = (B_MOE_END > B_MIX_END ? B_MOE_END : B_MIX_END);
constexpr size_t WS_NEED = WS_XR + 32 * MiB;
constexpr int CW_BAR = 4096;
constexpr int CW_ECNT = 16384;
constexpr int CW_SCAN = 24576;
constexpr int CW_KMAX = 20480;

constexpr int RING_BYTES = 131072;
constexpr int LDSCTL_OFF = RING_BYTES, MISC_OFF = LDSCTL_OFF + 320;
constexpr int LDS_BYTES = 147456;

#define GAS __attribute__((address_space(1)))
#define LAS __attribute__((address_space(3)))
typedef unsigned short bf16;
typedef unsigned v4u __attribute__((ext_vector_type(4)));
typedef unsigned v2u __attribute__((ext_vector_type(2)));
typedef float f32x4 __attribute__((ext_vector_type(4)));
typedef float f32x2 __attribute__((ext_vector_type(2)));
typedef GAS unsigned gu32;
#define RLX_AGENT __ATOMIC_RELAXED, __HIP_MEMORY_SCOPE_AGENT
#define LDS_WAIT() asm volatile("s_waitcnt lgkmcnt(0)" ::: "memory")
#define VM_WAIT() asm volatile("s_waitcnt vmcnt(0)" ::: "memory")
__device__ __forceinline__ unsigned f2bf(float f) { unsigned u = __builtin_bit_cast(unsigned, f); return (u + 0x7fffu + ((u >> 16) & 1u)) >> 16; }
__device__ __forceinline__ unsigned pk2(float lo, float hi) { return f2bf(lo) | (f2bf(hi) << 16); }
__device__ __forceinline__ float bf2f(bf16 h) { return __uint_as_float(((unsigned)h) << 16); }
__device__ __forceinline__ float blo(unsigned w) { return __uint_as_float(w << 16); }
__device__ __forceinline__ float bhi(unsigned w) { return __uint_as_float(w & 0xffff0000u); }

#define XB_TMO      128
#define XB_XCNT(j)  (256  + 64 * (j))
#define XB_XSUB(j)  (1280 + 64 * (j))
#define XB_XGEN(j)  (2304 + 64 * (j))
#define XB_TOP      3328
#define XB_TOPGEN   3392
#define XCD_BAR_WORDS 3456
#define XB_SPIN_CAP (1u << 18)
__device__ __forceinline__ unsigned xb_ld(unsigned* p)              { return __hip_atomic_load(p, __ATOMIC_RELAXED, __HIP_MEMORY_SCOPE_AGENT); }
__device__ __forceinline__ unsigned xb_add(unsigned* p, unsigned v) { return __hip_atomic_fetch_add(p, v, __ATOMIC_RELAXED, __HIP_MEMORY_SCOPE_AGENT); }
__device__ __forceinline__ unsigned xb_xcc_id() { return (unsigned)__builtin_amdgcn_s_getreg((3 << 11) | 20) & 0xFu; }
#define XB_SPIN(cond, bar) do { unsigned _sp = 0; while (cond) { __builtin_amdgcn_s_sleep(1); \
    if ((++_sp & 255u) == 0u) { if (xb_ld(&(bar)[XB_TMO])) break; if (_sp > XB_SPIN_CAP) { atomicAdd(&(bar)[XB_TMO], 1u); break; } } } } while (0)
struct XcdBarrier { unsigned* bar; unsigned x; volatile LAS unsigned* st; };
__device__ __forceinline__ XcdBarrier xcd_barrier_post(unsigned* bar, volatile LAS unsigned* st) {
    XcdBarrier b; b.bar = bar; b.x = xb_xcc_id(); b.st = st;
    if (threadIdx.x == 0) (void)xb_add(&bar[XB_XCNT(b.x)], 1u);
    return b;
}
__device__ __forceinline__ void xcd_barrier_complete(unsigned* bar, unsigned x, unsigned& nloc, unsigned& nx) {
    const unsigned G = gridDim.x * gridDim.y * gridDim.z;
    unsigned sum, cnt, mine, sp = 0u;
    for (;;) {
        sum = 0u; cnt = 0u; mine = 0u;
#pragma unroll
        for (unsigned j = 0; j < 16; ++j) { const unsigned c = xb_ld(&bar[XB_XCNT(j)]); sum += c; cnt += (c > 0u) ? 1u : 0u; mine = (j == x) ? c : mine; }
        if (sum == G) break;
        __builtin_amdgcn_s_sleep(1);
        if ((++sp & 255u) == 0u) { if (xb_ld(&bar[XB_TMO])) break; if (sp > XB_SPIN_CAP) { atomicAdd(&bar[XB_TMO], 1u); break; } }
    }
    nloc = mine > 0u ? mine : 1u; nx = cnt > 0u ? cnt : 1u;
}
__device__ __forceinline__ void xcd_barrier(const XcdBarrier& b) {
    asm volatile("s_waitcnt vmcnt(0)" ::: "memory");
    __syncthreads();
    if (threadIdx.x == 0) {
        unsigned* bar = b.bar;
        __builtin_amdgcn_s_waitcnt(0);
        asm volatile("buffer_inv sc1" ::: "memory");
        unsigned nloc = b.st[0], nx = b.st[1];
        if (nloc == 0u) { xcd_barrier_complete(bar, b.x, nloc, nx); b.st[0] = nloc; b.st[1] = nx; }
        const unsigned old = xb_add(&bar[XB_XSUB(b.x)], 1u);
        const unsigned gen = old / nloc;
        if (old + 1u == (gen + 1u) * nloc) {
            __builtin_amdgcn_fence(__ATOMIC_RELEASE, "agent");
            asm volatile("s_waitcnt vmcnt(0)" ::: "memory");
            const unsigned og = xb_add(&bar[XB_TOP], 1u);
            const unsigned tg = og / nx;
            if (og + 1u == (tg + 1u) * nx) xb_add(&bar[XB_TOPGEN], 1u);
            else XB_SPIN(xb_ld(&bar[XB_TOPGEN]) == tg, bar);
            asm volatile("" ::: "memory");
            xb_add(&bar[XB_XGEN(b.x)], 1u);
            asm volatile("s_waitcnt vmcnt(0)" ::: "memory");
        } else {
            XB_SPIN(xb_ld(&bar[XB_XGEN(b.x)]) == gen, bar);
            asm volatile("s_waitcnt vmcnt(0)" ::: "memory");
        }
    }
    __syncthreads();
}

template <int CTRL> __device__ __forceinline__ float dpp_f(float v) { return __builtin_bit_cast(float, __builtin_amdgcn_update_dpp(0, __builtin_bit_cast(int, v), CTRL, 0xf, 0xf, true)); }
template <int CTRL> __device__ __forceinline__ int dpp_i(int v) { return __builtin_amdgcn_update_dpp(0, v, CTRL, 0xf, 0xf, true); }
__device__ __forceinline__ float wave_sum(float v) {
    v += dpp_f<0xB1>(v); v += dpp_f<0x4E>(v); v += dpp_f<0x141>(v); v += dpp_f<0x140>(v);
    { auto r = __builtin_amdgcn_permlane16_swap(__float_as_uint(v), __float_as_uint(v), false, false); v = __uint_as_float(r[0]) + __uint_as_float(r[1]); }
    { auto r = __builtin_amdgcn_permlane32_swap(__float_as_uint(v), __float_as_uint(v), false, false); v = __uint_as_float(r[0]) + __uint_as_float(r[1]); }
    return v;
}
__device__ __forceinline__ float wave_max(float v) {
    v = fmaxf(v, dpp_f<0xB1>(v)); v = fmaxf(v, dpp_f<0x4E>(v)); v = fmaxf(v, dpp_f<0x141>(v)); v = fmaxf(v, dpp_f<0x140>(v));
    { auto r = __builtin_amdgcn_permlane16_swap(__float_as_uint(v), __float_as_uint(v), false, false); v = fmaxf(__uint_as_float(r[0]), __uint_as_float(r[1])); }
    { auto r = __builtin_amdgcn_permlane32_swap(__float_as_uint(v), __float_as_uint(v), false, false); v = fmaxf(__uint_as_float(r[0]), __uint_as_float(r[1])); }
    return v;
}
__device__ __forceinline__ int imin_(int a, int b) { return a < b ? a : b; }
__device__ __forceinline__ int wave_min_i(int v) {
    v = imin_(v, dpp_i<0xB1>(v)); v = imin_(v, dpp_i<0x4E>(v)); v = imin_(v, dpp_i<0x141>(v)); v = imin_(v, dpp_i<0x140>(v));
    { auto r = __builtin_amdgcn_permlane16_swap((unsigned)v, (unsigned)v, false, false); v = imin_((int)r[0], (int)r[1]); }
    { auto r = __builtin_amdgcn_permlane32_swap((unsigned)v, (unsigned)v, false, false); v = imin_((int)r[0], (int)r[1]); }
    return v;
}
__device__ __forceinline__ float half_sum(float v) { auto r = __builtin_amdgcn_permlane32_swap(__float_as_uint(v), __float_as_uint(v), false, false); return __uint_as_float(r[0]) + __uint_as_float(r[1]); }
#define WAVE_SYNC() do { asm volatile("s_waitcnt lgkmcnt(0)" ::: "memory"); __builtin_amdgcn_wave_barrier(); } while (0)

struct Ptrs {
    const float* in[26];
    float* out; unsigned char* ws;
    int ph_lo, ph_hi;
};
enum { I_X = 0, I_C, I_ADAW, I_ADAB, I_NMIX, I_NFFN, I_WIN, I_CKPE, I_CKW1, I_CKW2, I_CVPE, I_CVW1, I_CVW2, I_FBIAS, I_RNSA, I_RRET, I_RFOX, I_WOUT,
       I_FW1, I_FW3, I_FW2, I_ROUTER, I_MW1, I_MW3, I_MW2, I_FNORM };

template <int MAP> __device__ __forceinline__ const float* tj_src(const float* W0, const float* W1, int p) {
    if (MAP == 0) return W0 + p;
    if (MAP == 2) { const int G = p >> 5, c = p & 31; const int col = 16 * G + (c >> 3) * 4 + (c & 3); return (((c >> 2) & 1) ? W1 : W0) + col; }
    if (p < 1280) return W0 + p;
    if (p < 4352) return W0 + p + 24;
    if (p < 7424) return W0 + p + 32;
    const int i = p - 7424; if (i < 24) return W0 + 1280 + i; if (i < 32) return W0 + 4376 + (i - 24); return nullptr;
}
template <int MAP> __device__ __forceinline__ void transpose_item(const float* W0, const float* W1, int ldw, int K, bf16* WT, int ndest, int item, LAS float* scr, int lane) {
    const int nblk = ndest / 64, kb = item / nblk, nb = item - kb * nblk, k0 = 64 * kb, n0 = 64 * nb;
    const int kr2 = lane >> 4, n4 = lane & 15;
    const float* src0 = tj_src<MAP>(W0, W1, n0 + 4 * n4); const bool has = (MAP != 1) || (src0 != nullptr); const float* src = has ? src0 : W0;
    LAS unsigned* sc = (LAS unsigned*)scr;
    f32x4 a[8], b[8];
#pragma unroll
    for (int i = 0; i < 8; ++i) { const int k = k0 + 8 * i + 2 * kr2;
        const f32x4 va = *(const f32x4*)(src + (size_t)k * ldw), vb = *(const f32x4*)(src + (size_t)(k + 1) * ldw); const f32x4 z4 = {0.f, 0.f, 0.f, 0.f};
        a[i] = has ? va : z4; b[i] = has ? vb : z4; }
#pragma unroll
    for (int i = 0; i < 8; ++i) { const int kd = 4 * i + kr2;
        sc[(4 * n4 + 0) * 33 + kd] = pk2(a[i].x, b[i].x); sc[(4 * n4 + 1) * 33 + kd] = pk2(a[i].y, b[i].y); sc[(4 * n4 + 2) * 33 + kd] = pk2(a[i].z, b[i].z); sc[(4 * n4 + 3) * 33 + kd] = pk2(a[i].w, b[i].w); }
    LDS_WAIT(); asm volatile("" ::: "memory");
    const int c = lane & 7;
#pragma unroll
    for (int q = 0; q < 8; ++q) { const int n = (lane >> 3) + 8 * q; const LAS unsigned* s = sc + n * 33 + 4 * c;
        const v4u o = {s[0], s[1], s[2], s[3]};
        *(GAS v4u*)(WT + (size_t)(n0 + n) * K + k0 + 8 * c) = o; }
    LDS_WAIT(); asm volatile("" ::: "memory");
}
__device__ __forceinline__ int tj_items(int K, int ndest) { return (K / 64) * (ndest / 64); }

template <int R> __device__ __forceinline__ void att_scores(const char* kblk, unsigned koff, const LAS float* qs, float (&s)[R]) {
#pragma unroll
    for (int r = 0; r < R; ++r) s[r] = 0.f;
    v4u kq[8];
#pragma unroll
    for (int c = 0; c < 8; ++c) kq[c] = *(const v4u*)(kblk + (size_t)koff + 16 * c);
#pragma unroll
    for (int c = 0; c < 8; ++c) {
        const v4u kv = kq[c];
        const float k0 = blo(kv.x), k1 = bhi(kv.x), k2 = blo(kv.y), k3 = bhi(kv.y), k4 = blo(kv.z), k5 = bhi(kv.z), k6 = blo(kv.w), k7 = bhi(kv.w);
#pragma unroll
        for (int r = 0; r < R; ++r) { const f32x4 q0 = *(const LAS f32x4*)(qs + r * 64 + 8 * c), q1 = *(const LAS f32x4*)(qs + r * 64 + 8 * c + 4);
            s[r] += k0 * q0.x + k1 * q0.y + k2 * q0.z + k3 * q0.w + k4 * q1.x + k5 * q1.y + k6 * q1.z + k7 * q1.w; }
#pragma unroll
        for (int r = 0; r < R; ++r) asm volatile("" : "+v"(s[r]));
    }
}
template <int R, int LDVB> __device__ __forceinline__ void att_pv64(const char* vblk, unsigned loff, const LAS float* pb, float (&o)[R][2], int kh) {
#pragma unroll 2
    for (int kk = 0; kk < 32; kk += 4) {
        f32x4 p[R];
#pragma unroll
        for (int r = 0; r < R; ++r) p[r] = *(const LAS f32x4*)(pb + r * 64 + kh * 32 + kk);
#pragma unroll
        for (int q = 0; q < 4; ++q) { const unsigned w = *(const unsigned*)(vblk + (size_t)(2 * (kk + q)) * LDVB + (size_t)loff); const float v0 = blo(w), v1 = bhi(w);
#pragma unroll
            for (int r = 0; r < R; ++r) { o[r][0] += p[r][q] * v0; o[r][1] += p[r][q] * v1; } }
    }
}
template <int R> __device__ __forceinline__ void att_softmax_step(float (&s)[R], float (&m)[R], float (&l)[R], float (&o)[R][2], LAS float* pb, int lane) {
    const int slot = (lane & 1) * 32 + (lane >> 1);
#pragma unroll
    for (int r = 0; r < R; ++r) {
        const float bm = wave_max(s[r]); const float mn = fmaxf(m[r], bm);
        float p = 0.f, alpha = 1.f;
        if (mn > -INFINITY) { alpha = __expf(m[r] - mn); p = __expf(s[r] - mn); }
        l[r] = l[r] * alpha + p; o[r][0] *= alpha; o[r][1] *= alpha; m[r] = mn; pb[r * 64 + slot] = p;
    }
}

namespace fa {
typedef short bf16x8 __attribute__((ext_vector_type(8)));
typedef float f32x16 __attribute__((ext_vector_type(16)));
constexpr int ROWB = 144;
constexpr int TILEB = 64 * ROWB;
constexpr int VROWB = 192, VTILEB = 64 * VROWB;
constexpr int OFF_K = 0, OFF_V = 4 * TILEB, OFF_B = OFF_V + 4 * VTILEB, OFF_W = OFF_B + 8192, WAVEB = 4608;
constexpr float C2 = 0.125f * 1.4426950408889634f;
__device__ __forceinline__ int crow(int r, int hi) { return (r & 3) + 8 * (r >> 2) + 4 * hi; }
__device__ __forceinline__ int perm16(int t) { const int q4 = (t >> 2) & 3; return (q4 == 1) ? t + 4 : (q4 == 2) ? t - 4 : t; }
typedef float f32x2_t __attribute__((ext_vector_type(2))); typedef __bf16 bf16x2_t __attribute__((ext_vector_type(2)));
__device__ __forceinline__ unsigned cvtpk(float lo, float hi) { f32x2_t v = {lo, hi}; bf16x2_t b = __builtin_convertvector(v, bf16x2_t); return __builtin_bit_cast(unsigned, b); }
__device__ __forceinline__ float hmax(float v) { auto r = __builtin_amdgcn_permlane32_swap(__float_as_uint(v), __float_as_uint(v), false, false); return fmaxf(__uint_as_float(r[0]), __uint_as_float(r[1])); }

__device__ __forceinline__ void qk_tile(f32x16& p0, f32x16& p1, const LAS char* kb, const bf16x8 (&qr)[4], const f32x16& c0, const f32x16& c1) {
    bf16x8 a0[4], a1[4];
#pragma unroll
    for (int d0 = 0; d0 < 4; ++d0) { a0[d0] = *(const LAS bf16x8*)(kb + 32 * d0); a1[d0] = *(const LAS bf16x8*)(kb + 32 * ROWB + 32 * d0); }
    p0 = __builtin_amdgcn_mfma_f32_32x32x16_bf16(a0[0], qr[0], c0, 0, 0, 0); p1 = __builtin_amdgcn_mfma_f32_32x32x16_bf16(a1[0], qr[0], c1, 0, 0, 0);
#pragma unroll
    for (int d0 = 1; d0 < 4; ++d0) { p0 = __builtin_amdgcn_mfma_f32_32x32x16_bf16(a0[d0], qr[d0], p0, 0, 0, 0); p1 = __builtin_amdgcn_mfma_f32_32x32x16_bf16(a1[d0], qr[d0], p1, 0, 0, 0); }
}
struct VFrag { bf16x8 a0[4], a1[4]; };
typedef short v4i16_t __attribute__((ext_vector_type(4)));
__device__ __forceinline__ bf16x8 v_tr2(const LAS char* p) {
    const v4i16_t a = __builtin_amdgcn_ds_read_tr16_b64_v4i16((LAS v4i16_t*)p), b = __builtin_amdgcn_ds_read_tr16_b64_v4i16((LAS v4i16_t*)(p + 8 * VROWB));
    return (bf16x8){a.x, a.y, a.z, a.w, b.x, b.y, b.z, b.w}; }
__device__ __forceinline__ void v_load(VFrag& v, const LAS char* vb) {
#pragma unroll
    for (int s = 0; s < 4; ++s) { const int kb_ = 16 * (s & 1) + 32 * (s >> 1); v.a0[s] = v_tr2(vb + kb_ * VROWB); v.a1[s] = v_tr2(vb + kb_ * VROWB + 64); }
}
__device__ __forceinline__ void pv_mma(f32x16& o0, f32x16& o1, const VFrag& v, const f32x16& p0, const f32x16& p1) {
    bf16x8 pf[4];
#pragma unroll
    for (int s = 0; s < 4; ++s) { v4u w;
        if (s < 2) { const int b = 8 * s; w.x = cvtpk(p0[b], p0[b + 1]); w.y = cvtpk(p0[b + 2], p0[b + 3]); w.z = cvtpk(p0[b + 4], p0[b + 5]); w.w = cvtpk(p0[b + 6], p0[b + 7]); }
        else { const int b = 8 * (s - 2); w.x = cvtpk(p1[b], p1[b + 1]); w.y = cvtpk(p1[b + 2], p1[b + 3]); w.z = cvtpk(p1[b + 4], p1[b + 5]); w.w = cvtpk(p1[b + 6], p1[b + 7]); }
        pf[s] = __builtin_bit_cast(bf16x8, w); }
#pragma unroll
    for (int s = 0; s < 4; ++s) { o0 = __builtin_amdgcn_mfma_f32_32x32x16_bf16(v.a0[s], pf[s], o0, 0, 0, 0); o1 = __builtin_amdgcn_mfma_f32_32x32x16_bf16(v.a1[s], pf[s], o1, 0, 0, 0); }
}
__device__ __forceinline__ void pv_tile(f32x16& o0, f32x16& o1, const LAS char* vb, const f32x16& p0, const f32x16& p1) { VFrag v; v_load(v, vb); pv_mma(o0, o1, v, p0, p1); }
__device__ __forceinline__ float max3f(float a, float b, float c) { float r; asm("v_max3_f32 %0, %1, %2, %3" : "=v"(r) : "v"(a), "v"(b), "v"(c)); return r; }
template <bool WITH_O, bool PRE = false> __device__ __forceinline__ void softmax_update(f32x16& p0, f32x16& p1, float& m, float& l, f32x16& o0, f32x16& o1, bool active = true) {
    constexpr float SC = PRE ? 1.0f : C2;
    float mx = max3f(p0[0], p1[0], p0[1]);
    mx = max3f(mx, p1[1], p0[2]); mx = max3f(mx, p1[2], p0[3]); mx = max3f(mx, p1[3], p0[4]); mx = max3f(mx, p1[4], p0[5]); mx = max3f(mx, p1[5], p0[6]); mx = max3f(mx, p1[6], p0[7]);
    mx = max3f(mx, p1[7], p0[8]); mx = max3f(mx, p1[8], p0[9]); mx = max3f(mx, p1[9], p0[10]); mx = max3f(mx, p1[10], p0[11]); mx = max3f(mx, p1[11], p0[12]); mx = max3f(mx, p1[12], p0[13]);
    mx = max3f(mx, p1[13], p0[14]); mx = max3f(mx, p1[14], p0[15]); mx = fmaxf(mx, p1[15]);
    mx = active ? hmax(mx) * SC : -INFINITY;
    const float mnew = fmaxf(m, mx), msafe = (mnew == -INFINITY) ? 0.f : mnew;
    const float alpha = __builtin_amdgcn_exp2f(m - msafe);
    const float negm = active ? -msafe : -INFINITY;
    float sum = 0.f;
#pragma unroll
    for (int r = 0; r < 16; ++r) { p0[r] = __builtin_amdgcn_exp2f(PRE ? p0[r] + negm : __builtin_fmaf(p0[r], C2, negm)); p1[r] = __builtin_amdgcn_exp2f(PRE ? p1[r] + negm : __builtin_fmaf(p1[r], C2, negm)); sum += p0[r] + p1[r]; }
    l = l * alpha + sum; m = mnew;
    if (WITH_O) { if (__any(alpha != 1.0f)) {
#pragma unroll
        for (int r = 0; r < 16; ++r) { o0[r] *= alpha; o1[r] *= alpha; } } }
}
#define FAST_BOUND 88.0f
__device__ __forceinline__ void exp_sum(f32x16& p0, f32x16& p1, float& l) {
    float s0 = 0.f, s1 = 0.f;
#pragma unroll
    for (int r = 0; r < 16; ++r) { p0[r] = __builtin_amdgcn_exp2f(p0[r]); p1[r] = __builtin_amdgcn_exp2f(p1[r]); s0 += p0[r]; s1 += p1[r]; }
    l += s0 + s1;
}
__device__ __forceinline__ void pv_mma_keep(f32x16& o0, f32x16& o1, const VFrag& v, const f32x16& p0, const f32x16& p1, unsigned keep) {
    bf16x8 pf[4];
#pragma unroll
    for (int s = 0; s < 4; ++s) { v4u w;
        if (s < 2) { const int b = 8 * s; w.x = cvtpk(p0[b], p0[b + 1]); w.y = cvtpk(p0[b + 2], p0[b + 3]); w.z = cvtpk(p0[b + 4], p0[b + 5]); w.w = cvtpk(p0[b + 6], p0[b + 7]); }
        else { const int b = 8 * (s - 2); w.x = cvtpk(p1[b], p1[b + 1]); w.y = cvtpk(p1[b + 2], p1[b + 3]); w.z = cvtpk(p1[b + 4], p1[b + 5]); w.w = cvtpk(p1[b + 6], p1[b + 7]); }
        w.x &= keep; w.y &= keep; w.z &= keep; w.w &= keep;
        pf[s] = __builtin_bit_cast(bf16x8, w); }
#pragma unroll
    for (int s = 0; s < 4; ++s) { o0 = __builtin_amdgcn_mfma_f32_32x32x16_bf16(v.a0[s], pf[s], o0, 0, 0, 0); o1 = __builtin_amdgcn_mfma_f32_32x32x16_bf16(v.a1[s], pf[s], o1, 0, 0, 0); }
}
struct Stage { v4u k, v; };
}
#define FA_LOAD_(SET, II, TMAP_, KG_, KTB_, KSO_, VG_, VSO_, BIAS_) do { const int i_ = ((II) < n_steps_) ? (II) : n_steps_ - 1; const int t = __builtin_amdgcn_readfirstlane(TMAP_(i_)); \
        const char* kg_ = (KG_) + (size_t)t * (KTB_); const char* vg_ = (VG_) + (size_t)t * (KTB_); asm volatile("" : "+s"(kg_), "+s"(vg_)); \
        k##SET = *(const GAS v4u*)((const GAS char*)kg_ + (size_t)(KSO_)); v##SET = *(const GAS v4u*)((const GAS char*)vg_ + (size_t)(VSO_)); b##SET = (BIAS_); } while (0)
#define FA_COMMIT_(SET, BUF, BFIN_) do { *(LAS v4u*)(L + fa::OFF_K + (BUF) * fa::TILEB + sdst) = k##SET; *(LAS v4u*)(L + fa::OFF_V + (BUF) * fa::VTILEB + sdstv) = v##SET; \
        if (bias_all_) { const float x = b##SET; ((LAS float*)(L + fa::OFF_B))[((BUF) * 8 + (tid >> 6)) * 64 + (tid & 63)] = (BFIN_); } } while (0)
#define FA_BAR_() do { asm volatile("s_waitcnt lgkmcnt(0)" ::: "memory"); __builtin_amdgcn_s_barrier(); asm volatile("" ::: "memory"); } while (0)
#define FA_BODY_(TMAP_P_, I_, SLOT_, ...) { const int t = TMAP_P_(I_); const int cb = (SLOT_); const LAS char* kb = kb0 + (SLOT_) * fa::TILEB; const LAS char* vb = vb0 + (SLOT_) * fa::VTILEB; (void)kb; (void)vb; (void)cb; (void)t; __VA_ARGS__ }
#define FA_COMMITP_(ST_, BFIN_) do { FA_COMMIT_(A_, 2 * (ST_), BFIN_); FA_COMMIT_(B_, 2 * (ST_) + 1, BFIN_); } while (0)
#define FA_LOOP2(NSTEPS, TMAP, KG, KTILEB, KSO, VG, VSO, BIAS_EXPR, BIAS_FIN, EXIT_EXPR, ...) do { \
    const int n_steps_ = (NSTEPS); \
    v4u kA_, vA_, kB_, vB_; float bA_, bB_; \
    FA_LOAD_(A_, 0, TMAP, KG, KTILEB, KSO, VG, VSO, BIAS_EXPR); FA_LOAD_(B_, 1, TMAP, KG, KTILEB, KSO, VG, VSO, BIAS_EXPR); FA_COMMITP_(0, BIAS_FIN); \
    FA_LOAD_(A_, 2, TMAP, KG, KTILEB, KSO, VG, VSO, BIAS_EXPR); FA_LOAD_(B_, 3, TMAP, KG, KTILEB, KSO, VG, VSO, BIAS_EXPR); \
    FA_BAR_(); \
    _Pragma("unroll 1") for (int i4_ = 0; i4_ < n_steps_; i4_ += 4) { \
        { if (EXIT_EXPR) break; \
          FA_BODY_(TMAP, i4_, 0, __VA_ARGS__) \
          if (i4_ + 1 < n_steps_) FA_BODY_(TMAP, i4_ + 1, 1, __VA_ARGS__) \
          if (i4_ + 2 < n_steps_) FA_COMMITP_(1, BIAS_FIN); \
          FA_LOAD_(A_, i4_ + 4, TMAP, KG, KTILEB, KSO, VG, VSO, BIAS_EXPR); FA_LOAD_(B_, i4_ + 5, TMAP, KG, KTILEB, KSO, VG, VSO, BIAS_EXPR); \
          FA_BAR_(); } \
        if (i4_ + 2 < n_steps_) { if (EXIT_EXPR) break; \
          FA_BODY_(TMAP, i4_ + 2, 2, __VA_ARGS__) \
          if (i4_ + 3 < n_steps_) FA_BODY_(TMAP, i4_ + 3, 3, __VA_ARGS__) \
          if (i4_ + 4 < n_steps_) FA_COMMITP_(0, BIAS_FIN); \
          FA_LOAD_(A_, i4_ + 6, TMAP, KG, KTILEB, KSO, VG, VSO, BIAS_EXPR); FA_LOAD_(B_, i4_ + 7, TMAP, KG, KTILEB, KSO, VG, VSO, BIAS_EXPR); \
          FA_BAR_(); } \
    } FA_BAR_(); } while (0)
#define FA_TMAP_UP_(i) (t_lo_up_ + (i))
#define FA_LOOP(T_LO, T_HI, KG, KTILEB, KSO, VG, VSO, BIAS_EXPR, BIAS_FIN, ...) do { const int t_lo_up_ = (T_LO); FA_LOOP2((T_HI) - t_lo_up_ + 1, FA_TMAP_UP_, KG, KTILEB, KSO, VG, VSO, BIAS_EXPR, BIAS_FIN, false, __VA_ARGS__); } while (0)
#define CR(r) (((r) & 3) + 8 * ((r) >> 2))

#define FOX_THR 26.0f
__device__ __forceinline__ void fox_unit(LAS unsigned char* lds, unsigned char* ws, int L_, int b, int h, int qb, int tid, int wave, int lane) {
    using fa::bf16x8; using fa::f32x16;
    asm volatile("" : "+v"(lane), "+v"(tid));
    const int r32 = lane & 31, hi = lane >> 5;
    const int q0 = qb * 256, qw = q0 + 32 * wave;
    const size_t mrow = (size_t)b * T;
    const char* Qg = (const char*)(ws + B_FOX) + (mrow + qw) * 3072 + h * 128;
    const char* Kg = (const char*)(ws + B_FOX) + mrow * 3072 + 1024 + h * 128;
    const char* Vg = (const char*)(ws + B_FOX) + mrow * 3072 + 2048 + h * 128;
    const float* cu = (const float*)(ws + WS_CUM) + (size_t)(b * 8 + h) * T;
    bf16x8 qr[4]; float qn2 = 0.f;
_Pragma("unroll")
    for (int d0 = 0; d0 < 4; ++d0) { const v4u w = *(const v4u*)(Qg + (size_t)(unsigned)(r32 * 3072 + d0 * 32 + hi * 16)); qr[d0] = __builtin_bit_cast(bf16x8, w);
        qn2 += blo(w.x) * blo(w.x) + bhi(w.x) * bhi(w.x) + blo(w.y) * blo(w.y) + bhi(w.y) * bhi(w.y) + blo(w.z) * blo(w.z) + bhi(w.z) * bhi(w.z) + blo(w.w) * blo(w.w) + bhi(w.w) * bhi(w.w); }
    constexpr bool bias_all_ = true;
    const float kmax = sqrtf(__uint_as_float(((const unsigned*)(ws + WS_CTL))[CW_KMAX + 32 * L_ + b * 8 + h]));
    const float qk_ub = sqrtf(half_sum(qn2)) * kmax * 1.001f;
    const int srow = tid >> 3, sch = tid & 7;
    const unsigned kso = (unsigned)(srow * 3072 + sch * 16), vso = kso, sdst = (unsigned)(srow * fa::ROWB + sch * 16), sdstv = (unsigned)(srow * fa::VROWB + sch * 16);
    const float cwv = cu[q0 + 32 * (tid >> 6)];
    const float span = 1.4426950408889634f * fabsf(cu[qw + 31] - cu[qw]);
    const bool fastw = __all(qk_ub + span < FAST_BOUND);
    LAS char* L = (LAS char*)lds;
    const LAS char* kb0 = L + fa::OFF_K + r32 * fa::ROWB + hi * 16; const LAS char* vb0 = L + fa::OFF_V + (4 * hi + ((lane & 15) >> 2)) * fa::VROWB + (16 * ((lane >> 4) & 1) + 4 * (lane & 3)) * 2;
    LAS unsigned* done_f = (LAS unsigned*)(L + fa::OFF_W);
    if (tid < 32) done_f[tid] = 0u;
    float m = -INFINITY, l = 0.f; f32x16 o0, o1;
_Pragma("unroll")
    for (int r = 0; r < 16; ++r) { o0[r] = 0.f; o1[r] = 0.f; }
    const int NT = 4 * qb + 4;
    int step_ = 0;
#define FOX_TMAP_(i) (NT - 1 - (i))
#define FOX_EXIT_ (step_ > 0 && __builtin_amdgcn_readfirstlane((int)(done_f[((step_ - 1) & 3) * 8 + 0] & done_f[((step_ - 1) & 3) * 8 + 1] & done_f[((step_ - 1) & 3) * 8 + 2] & done_f[((step_ - 1) & 3) * 8 + 3] & \
                        done_f[((step_ - 1) & 3) * 8 + 4] & done_f[((step_ - 1) & 3) * 8 + 5] & done_f[((step_ - 1) & 3) * 8 + 6] & done_f[((step_ - 1) & 3) * 8 + 7])) != 0)
#define FOX_BODY_(REF_, SOFTMAX_) { \
        bool mydone = false; \
        if (64 * t <= qw + 31) { \
            const LAS float* bl = (const LAS float*)(L + fa::OFF_B) + (cb * 8 + wave) * 64; \
              \
            const float ub2 = qk_ub + bl[63]; \
            mydone = __all(ub2 < (REF_) - FOX_THR); \
            if (!mydone) { \
                f32x16 c0, c1; const LAS float* blh = bl + 4 * hi; \
_Pragma("unroll") \
                for (int k4 = 0; k4 < 4; ++k4) { const f32x4 x = *(const LAS f32x4*)(blh + 8 * k4), y = *(const LAS f32x4*)(blh + 32 + 8 * k4); \
                    c0[4 * k4] = x.x; c0[4 * k4 + 1] = x.y; c0[4 * k4 + 2] = x.z; c0[4 * k4 + 3] = x.w; c1[4 * k4] = y.x; c1[4 * k4 + 1] = y.y; c1[4 * k4 + 2] = y.z; c1[4 * k4 + 3] = y.w; } \
                f32x16 p0, p1; fa::qk_tile(p0, p1, kb, qr, c0, c1); fa::VFrag vf; fa::v_load(vf, vb); \
                if (64 * t + 63 > qw) { int qq = qw + r32 - 64 * t - 4 * hi; asm volatile("" : "+v"(qq));        \
_Pragma("unroll") \
                    for (int r = 0; r < 16; ++r) { if (CR(r) > qq) p0[r] = -INFINITY; if (CR(r) + 32 > qq) p1[r] = -INFINITY; } } \
                SOFTMAX_; \
                fa::pv_mma(o0, o1, vf, p0, p1); \
            } \
        } \
        if (lane == 0) done_f[(step_ & 3) * 8 + wave] = mydone ? 1u : 0u; \
        ++step_; }
    if (fastw) {
        FA_LOOP2(NT, FOX_TMAP_, Kg, 64 * 3072, kso, Vg, vso, cu[t * 64 + (tid & 63)], 1.4426950408889634f * (cwv - x), FOX_EXIT_, FOX_BODY_(__builtin_amdgcn_logf(l), fa::exp_sum(p0, p1, l)));
    } else {
        FA_LOOP2(NT, FOX_TMAP_, Kg, 64 * 3072, kso, Vg, vso, cu[t * 64 + (tid & 63)], 1.4426950408889634f * (cwv - x), FOX_EXIT_, FOX_BODY_(m, (fa::softmax_update<true, true>(p0, p1, m, l, o0, o1))));
    }
#undef FOX_BODY_
#undef FOX_EXIT_
#undef FOX_TMAP_
    const float inv = 1.0f / half_sum(l);
    char* Og = (char*)(ws + B_OATT) + ((size_t)2 * M + mrow + qw + r32) * 1024 + (h * 64) * 2;
_Pragma("unroll")
    for (int k4 = 0; k4 < 4; ++k4) {
        *(v2u*)(Og + (8 * k4 + 4 * hi) * 2) = (v2u){fa::cvtpk(o0[4 * k4] * inv, o0[4 * k4 + 1] * inv), fa::cvtpk(o0[4 * k4 + 2] * inv, o0[4 * k4 + 3] * inv)};
        *(v2u*)(Og + (32 + 8 * k4 + 4 * hi) * 2) = (v2u){fa::cvtpk(o1[4 * k4] * inv, o1[4 * k4 + 1] * inv), fa::cvtpk(o1[4 * k4 + 2] * inv, o1[4 * k4 + 3] * inv)};
    }
}

__device__ __forceinline__ void nsa_unit(LAS unsigned char* lds, unsigned char* ws, int L_, int b, int g, int qblk, int tid, int wave, int lane) {
    using fa::bf16x8; using fa::f32x16;
    constexpr bool bias_all_ = false;
    asm volatile("" : "+v"(lane), "+v"(tid));
    const int r32 = lane & 31, hi = lane >> 5, qi = r32 & 7, hd = r32 >> 3;
    const int q0 = 64 * qblk, cur = qblk, bg = b * 2 + g;
    const int q = q0 + 8 * wave + qi;
    const size_t mrow = (size_t)b * T;
    const char* Qg = (const char*)(ws + B_NQ) + (mrow + q) * 1024 + ((g * 4 + hd) * 64) * 2;
    bf16x8 qr[4];
_Pragma("unroll")
    for (int d0 = 0; d0 < 4; ++d0) qr[d0] = *(const bf16x8*)(Qg + d0 * 32 + hi * 16);
    bool fastw;
    { float qn2 = 0.f;
_Pragma("unroll")
      for (int d0 = 0; d0 < 4; ++d0) { const v4u w = __builtin_bit_cast(v4u, qr[d0]);
        qn2 += blo(w.x) * blo(w.x) + bhi(w.x) * bhi(w.x) + blo(w.y) * blo(w.y) + bhi(w.y) * bhi(w.y) + blo(w.z) * blo(w.z) + bhi(w.z) * bhi(w.z) + blo(w.w) * blo(w.w) + bhi(w.w) * bhi(w.w); }
      const float kmx = sqrtf(__uint_as_float(((const unsigned*)(ws + WS_CTL))[CW_KMAX + 32 * L_ + 16]));
      fastw = __all(sqrtf(half_sum(qn2)) * kmx * 1.02f < FAST_BOUND); }
    const float* gl = (const float*)(ws + WS_SMALL) + (mrow + q) * 32 + g * 4 + hd;
    const float g0 = pg8::sigmoidf_(gl[0]), g1 = pg8::sigmoidf_(gl[8]), g2 = pg8::sigmoidf_(gl[16]);
    const int srow = tid >> 3, sch = tid & 7;
    const unsigned sdst = (unsigned)(srow * fa::ROWB + sch * 16), sdstv = (unsigned)(srow * fa::VROWB + sch * 16);
    LAS char* L = (LAS char*)lds;
    const LAS char* kb0 = L + fa::OFF_K + r32 * fa::ROWB + hi * 16; const LAS char* vb0 = L + fa::OFF_V + (4 * hi + ((lane & 15) >> 2)) * fa::VROWB + (16 * ((lane >> 4) & 1) + 4 * (lane & 3)) * 2;
    LAS float* imp = (LAS float*)(L + fa::OFF_W + wave * fa::WAVEB); LAS unsigned* selm = (LAS unsigned*)(imp + 8 * 132);
    for (int i = lane; i < 8 * 132; i += 64) imp[i] = 0.f;
    f32x16 zc;
_Pragma("unroll")
    for (int r = 0; r < 16; ++r) zc[r] = 0.f;
    f32x16 ot0 = zc, ot1 = zc;
    {
        const char* Kc = (const char*)(ws + WS_CC) + (size_t)bg * 512 * 128; const char* Vc = (const char*)(ws + WS_CCVT) + (size_t)bg * 512 * 128;
        const unsigned kso = (unsigned)(srow * 128 + sch * 16), vso = kso;
        const int ntc = ((4 * cur + 2) >> 6);
        const int nq = (q >= 31) ? ((q - 31) >> 4) : -1;
        float m1 = -INFINITY, l1 = 0.f; f32x16 o0 = zc, o1 = zc;
#define CMP_MASK_() { int nn = nq - 64 * t - 4 * hi; asm volatile("" : "+v"(nn)); if (__any(nn < 63)) { \
_Pragma("unroll") \
            for (int r = 0; r < 16; ++r) { if (CR(r) > nn) p0[r] = -INFINITY; if (CR(r) + 32 > nn) p1[r] = -INFINITY; } } }
        if (fastw) {
            FA_LOOP(0, ntc, Kc, 64 * 128, kso, Vc, vso, 0.f, 0.f * x, {
                f32x16 p0, p1; fa::qk_tile(p0, p1, kb, qr, zc, zc);
                CMP_MASK_();
                fa::exp_sum(p0, p1, l1);
            });
            m1 = 0.f;
        } else {
            FA_LOOP(0, ntc, Kc, 64 * 128, kso, Vc, vso, 0.f, 0.f * x, {
                f32x16 p0, p1; fa::qk_tile(p0, p1, kb, qr, zc, zc);
                CMP_MASK_();
                fa::softmax_update<false, true>(p0, p1, m1, l1, o0, o1);
            });
        }
        const float lt = half_sum(l1); const float invl = (lt > 0.f) ? 1.0f / lt : 0.f; const float nmsafe = (m1 == -INFINITY) ? 0.f : -m1;
        FA_LOOP(0, ntc, Kc, 64 * 128, kso, Vc, vso, 0.f, 0.f * x, {
            f32x16 p0, p1; fa::qk_tile(p0, p1, kb, qr, zc, zc); fa::VFrag vf; fa::v_load(vf, vb);
            CMP_MASK_();
_Pragma("unroll")
            for (int r = 0; r < 16; ++r) { p0[r] = __builtin_amdgcn_exp2f(p0[r] + nmsafe) * invl; p1[r] = __builtin_amdgcn_exp2f(p1[r] + nmsafe) * invl; }
_Pragma("unroll")
            for (int k4 = 0; k4 < 8; ++k4) {
                float gs, p3;
                if (k4 < 4) { gs = (p0[4 * k4] + p0[4 * k4 + 1]) + (p0[4 * k4 + 2] + p0[4 * k4 + 3]); p3 = p0[4 * k4 + 3]; }
                else { gs = (p1[4 * k4 - 16] + p1[4 * k4 - 15]) + (p1[4 * k4 - 14] + p1[4 * k4 - 13]); p3 = p1[4 * k4 - 13]; }
                gs += dpp_f<0x128>(gs); p3 += dpp_f<0x128>(p3);
                { auto r_ = __builtin_amdgcn_permlane16_swap(__float_as_uint(gs), __float_as_uint(gs), false, false); gs = __uint_as_float(r_[0]) + __uint_as_float(r_[1]); }
                { auto r_ = __builtin_amdgcn_permlane16_swap(__float_as_uint(p3), __float_as_uint(p3), false, false); p3 = __uint_as_float(r_[0]) + __uint_as_float(r_[1]); }
                const int j = 16 * t + ((k4 < 4) ? 2 * k4 : 8 + 2 * (k4 - 4)) + hi;
                if (hd == 0) { atomicAdd((float*)(imp + qi * 132 + j), gs); atomicAdd((float*)(imp + qi * 132 + j + 1), p3); }
            }
            fa::pv_mma(o0, o1, vf, p0, p1);
        });
#undef CMP_MASK_
_Pragma("unroll")
        for (int r = 0; r < 16; ++r) { ot0[r] = g0 * o0[r]; ot1[r] = g0 * o1[r]; }
    }
    WAVE_SYNC();
    {
        const int j0 = lane, j1 = lane + 64;
_Pragma("unroll 1")
        for (int q4 = 0; q4 < 8; q4 += 4) {
            unsigned key0[4], key1[4], Tk[4];
_Pragma("unroll")
            for (int i = 0; i < 4; ++i) { const int qq = q4 + i;
                const float s0 = (j0 == 0 || j0 == cur || j0 == cur - 1) ? 1e4f : imp[qq * 132 + j0], s1 = (j1 == cur || j1 == cur - 1) ? 1e4f : imp[qq * 132 + j1];
                key0[i] = (j0 <= cur) ? __float_as_uint(s0) + 1u : 0u; key1[i] = (j1 <= cur) ? __float_as_uint(s1) + 1u : 0u; Tk[i] = 0u; }
            if (cur + 1 > 16) {
_Pragma("unroll 1")
                for (int bit = 30; bit >= 0; --bit) {
_Pragma("unroll")
                    for (int i = 0; i < 4; ++i) { const unsigned cand = Tk[i] | (1u << bit);
                        const int c = __builtin_popcountll(__ballot(key0[i] >= cand)) + __builtin_popcountll(__ballot(key1[i] >= cand));
                        if (c >= 16) Tk[i] = cand; } }
            }
_Pragma("unroll")
            for (int i = 0; i < 4; ++i) { const int qq = q4 + i;
                bool sel0 = key0[i] != 0u, sel1 = key1[i] != 0u;
                if (cur + 1 > 16) {
                    const bool gt0 = key0[i] > Tk[i], gt1 = key1[i] > Tk[i], eq0 = key0[i] == Tk[i], eq1 = key1[i] == Tk[i];
                    const int need = 16 - (__builtin_popcountll(__ballot(gt0)) + __builtin_popcountll(__ballot(gt1)));
                    const unsigned long long be0 = __ballot(eq0), be1 = __ballot(eq1);
                    const int rank0 = (int)__builtin_amdgcn_mbcnt_hi((unsigned)(be0 >> 32), __builtin_amdgcn_mbcnt_lo((unsigned)be0, 0u)), rank1 = __builtin_popcountll(be0) + (int)__builtin_amdgcn_mbcnt_hi((unsigned)(be1 >> 32), __builtin_amdgcn_mbcnt_lo((unsigned)be1, 0u));
                    sel0 = gt0 || (eq0 && rank0 < need); sel1 = gt1 || (eq1 && rank1 < need);
                }
                const unsigned long long b0 = __ballot(sel0), b1 = __ballot(sel1);
                if (lane == 0) { selm[qq * 4 + 0] = (unsigned)b0; selm[qq * 4 + 1] = (unsigned)(b0 >> 32); selm[qq * 4 + 2] = (unsigned)b1; selm[qq * 4 + 3] = (unsigned)(b1 >> 32); } }
        }
    }
    WAVE_SYNC();
    {
        const unsigned sm0 = selm[qi * 4 + 0], sm1 = selm[qi * 4 + 1], sm2 = selm[qi * 4 + 2], sm3 = selm[qi * 4 + 3];
        const char* Ks = (const char*)(ws + B_KV) + mrow * 1536 + (256 + g * 64) * 2; const char* Vs = (const char*)(ws + B_KV) + mrow * 1536 + (384 + g * 64) * 2;
        const unsigned kso = (unsigned)(srow * 1536 + sch * 16), vso = kso;
        float m = -INFINITY, l = 0.f; f32x16 o0 = zc, o1 = zc;
#define SEL_DIAG_() if (t == cur) { int qq = q - 64 * t - 4 * hi; asm volatile("" : "+v"(qq));         \
_Pragma("unroll") \
                    for (int r = 0; r < 16; ++r) { if (CR(r) > qq) p0[r] = -INFINITY; if (CR(r) + 32 > qq) p1[r] = -INFINITY; } }
        if (fastw) {
            FA_LOOP(0, cur, Ks, 64 * 1536, kso, Vs, vso, 0.f, 0.f * x, {
                const unsigned wsel = (t < 32) ? sm0 : (t < 64) ? sm1 : (t < 96) ? sm2 : sm3;
                const bool sel = (wsel >> (t & 31)) & 1u;
                if (__any(sel)) {
                    f32x16 p0, p1; fa::qk_tile(p0, p1, kb, qr, zc, zc); fa::VFrag vf; fa::v_load(vf, vb);
                    SEL_DIAG_()
                    float ls = 0.f; fa::exp_sum(p0, p1, ls);
                    l += sel ? ls : 0.f;
                    fa::pv_mma_keep(o0, o1, vf, p0, p1, sel ? 0xFFFFFFFFu : 0u);
                }
            });
        } else {
            FA_LOOP(0, cur, Ks, 64 * 1536, kso, Vs, vso, 0.f, 0.f * x, {
                const unsigned wsel = (t < 32) ? sm0 : (t < 64) ? sm1 : (t < 96) ? sm2 : sm3;
                const bool sel = (wsel >> (t & 31)) & 1u;
                if (__any(sel)) {
                    f32x16 p0, p1; fa::qk_tile(p0, p1, kb, qr, zc, zc); fa::VFrag vf; fa::v_load(vf, vb);
                    SEL_DIAG_()
                    fa::softmax_update<true, true>(p0, p1, m, l, o0, o1, sel);
                    fa::pv_mma(o0, o1, vf, p0, p1);
                }
            });
        }
#undef SEL_DIAG_
        const float sc = g1 / half_sum(l);
_Pragma("unroll")
        for (int r = 0; r < 16; ++r) { ot0[r] += sc * o0[r]; ot1[r] += sc * o1[r]; }
    }
    {
        const char* Kw = (const char*)(ws + B_KV) + mrow * 1536 + (512 + g * 64) * 2; const char* Vw = (const char*)(ws + B_KV) + mrow * 1536 + (640 + g * 64) * 2;
        const unsigned kso = (unsigned)(srow * 1536 + sch * 16), vso = kso;
        float m = -INFINITY, l = 0.f; f32x16 o0 = zc, o1 = zc;
        const int tlo = (cur >= 8) ? cur - 8 : 0;
#define WIN_EDGE_() if (t == cur || t == cur - 8) { int qhi = q - 64 * t - 4 * hi, qlo = q - 511 - 64 * t - 4 * hi; asm volatile("" : "+v"(qhi), "+v"(qlo));     \
_Pragma("unroll") \
                for (int r = 0; r < 16; ++r) { if (CR(r) > qhi || CR(r) < qlo) p0[r] = -INFINITY; if (CR(r) + 32 > qhi || CR(r) + 32 < qlo) p1[r] = -INFINITY; } }
        if (fastw) {
            FA_LOOP(tlo, cur, Kw, 64 * 1536, kso, Vw, vso, 0.f, 0.f * x, {
                f32x16 p0, p1; fa::qk_tile(p0, p1, kb, qr, zc, zc); fa::VFrag vf; fa::v_load(vf, vb);
                WIN_EDGE_()
                fa::exp_sum(p0, p1, l);
                fa::pv_mma(o0, o1, vf, p0, p1);
            });
        } else {
            FA_LOOP(tlo, cur, Kw, 64 * 1536, kso, Vw, vso, 0.f, 0.f * x, {
                f32x16 p0, p1; fa::qk_tile(p0, p1, kb, qr, zc, zc); fa::VFrag vf; fa::v_load(vf, vb);
                WIN_EDGE_()
                fa::softmax_update<true, true>(p0, p1, m, l, o0, o1);
                fa::pv_mma(o0, o1, vf, p0, p1);
            });
        }
#undef WIN_EDGE_
        const float sc = g2 / half_sum(l);
_Pragma("unroll")
        for (int r = 0; r < 16; ++r) { ot0[r] += sc * o0[r]; ot1[r] += sc * o1[r]; }
    }
    char* Og = (char*)(ws + B_OATT) + (mrow + q) * 1024 + ((g * 4 + hd) * 64) * 2;
_Pragma("unroll")
    for (int k4 = 0; k4 < 4; ++k4) {
        *(v2u*)(Og + (8 * k4 + 4 * hi) * 2) = (v2u){fa::cvtpk(ot0[4 * k4], ot0[4 * k4 + 1]), fa::cvtpk(ot0[4 * k4 + 2], ot0[4 * k4 + 3])};
        *(v2u*)(Og + (32 + 8 * k4 + 4 * hi) * 2) = (v2u){fa::cvtpk(ot1[4 * k4], ot1[4 * k4 + 1]), fa::cvtpk(ot1[4 * k4 + 2], ot1[4 * k4 + 3])};
    }
}

__device__ __forceinline__ void ret_unit(unsigned char* ws, int bh, int c, int qg, int lane) {
    using fa::bf16x8; using fa::f32x16;
    asm volatile("" : "+v"(lane));
    const int r32 = lane & 31, hi = lane >> 5;
    const int b = bh >> 2, h = bh & 3, n = 32 * qg + r32;
    const float lg2 = log2f(1.0f - exp2f(-5.0f - (float)h));
    const size_t row0 = (size_t)b * T + c * 128;
    const char* Rq = (const char*)(ws + B_RET) + (row0 + n) * 3072 + h * 128 + hi * 16;
    bf16x8 qr[4];
_Pragma("unroll")
    for (int d0 = 0; d0 < 4; ++d0) qr[d0] = *(const bf16x8*)(Rq + d0 * 32);
    const bool two_kt = (32 * qg + 31 >= 64);
    const char* Kg = (const char*)(ws + B_RET) + row0 * 3072 + (256 + h * 64) * 2 + (size_t)r32 * 3072 + hi * 16;
    const char* Vg = (const char*)(ws + B_RVT) + ((size_t)(bh * 128 + r32) * T + c * 128 + 8 * hi) * 2;
    const char* sp = (const char*)(ws + B_RS) + ((size_t)(bh * 64 + c) * 8192 + (size_t)r32 * 64 + 8 * hi) * 2;
    bf16x8 kf0[2][4], kf1[2][4], sa0[2][4], sa1[2][4];
_Pragma("unroll")
    for (int d0 = 0; d0 < 4; ++d0) { kf0[0][d0] = *(const bf16x8*)(Kg + d0 * 32); kf1[0][d0] = *(const bf16x8*)(Kg + (size_t)32 * 3072 + d0 * 32); }
_Pragma("unroll")
    for (int eh = 0; eh < 2; ++eh)
_Pragma("unroll")
        for (int d0 = 0; d0 < 4; ++d0) { sa0[eh][d0] = *(const bf16x8*)(sp + (size_t)(64 * eh) * 128 + d0 * 32); sa1[eh][d0] = *(const bf16x8*)(sp + (size_t)(64 * eh + 32) * 128 + d0 * 32); }
    if (two_kt) {
_Pragma("unroll")
        for (int d0 = 0; d0 < 4; ++d0) { kf0[1][d0] = *(const bf16x8*)(Kg + (size_t)64 * 3072 + d0 * 32); kf1[1][d0] = *(const bf16x8*)(Kg + (size_t)96 * 3072 + d0 * 32); } }
    f32x16 acc[2][2];
_Pragma("unroll")
    for (int eh = 0; eh < 2; ++eh)
_Pragma("unroll")
        for (int tl = 0; tl < 2; ++tl)
_Pragma("unroll")
            for (int r = 0; r < 16; ++r) acc[eh][tl][r] = 0.f;
_Pragma("unroll")
    for (int eh = 0; eh < 2; ++eh)
_Pragma("unroll")
        for (int d0 = 0; d0 < 4; ++d0) { acc[eh][0] = __builtin_amdgcn_mfma_f32_32x32x16_bf16(sa0[eh][d0], qr[d0], acc[eh][0], 0, 0, 0); acc[eh][1] = __builtin_amdgcn_mfma_f32_32x32x16_bf16(sa1[eh][d0], qr[d0], acc[eh][1], 0, 0, 0); }
    const float g128 = exp2f(-128.0f * lg2);
_Pragma("unroll")
    for (int kt = 0; kt < 2; ++kt) {
        if (kt == 0 || two_kt) {
            bf16x8 v0[2][4], v1[2][4];
_Pragma("unroll")
            for (int eh = 0; eh < 2; ++eh)
_Pragma("unroll")
                for (int s = 0; s < 4; ++s) { v0[eh][s] = *(const bf16x8*)(Vg + (size_t)(64 * eh) * T * 2 + (64 * kt + 16 * s) * 2); v1[eh][s] = *(const bf16x8*)(Vg + (size_t)(64 * eh + 32) * T * 2 + (64 * kt + 16 * s) * 2); }
            f32x16 p0, p1;
_Pragma("unroll")
            for (int r = 0; r < 16; ++r) { p0[r] = 0.f; p1[r] = 0.f; }
_Pragma("unroll")
            for (int d0 = 0; d0 < 4; ++d0) { p0 = __builtin_amdgcn_mfma_f32_32x32x16_bf16(kf0[kt][d0], qr[d0], p0, 0, 0, 0); p1 = __builtin_amdgcn_mfma_f32_32x32x16_bf16(kf1[kt][d0], qr[d0], p1, 0, 0, 0); }
            int qq = n - 64 * kt - 4 * hi; asm volatile("" : "+v"(qq));
_Pragma("unroll")
            for (int r = 0; r < 16; ++r) { p0[r] = (CR(r) > qq) ? 0.f : p0[r] * g128; p1[r] = (CR(r) + 32 > qq) ? 0.f : p1[r] * g128; }
            bf16x8 pf[4];
_Pragma("unroll")
            for (int s = 0; s < 4; ++s) { v4u w;
                if (s < 2) { const int b8 = 8 * s; w.x = fa::cvtpk(p0[b8], p0[b8 + 1]); w.y = fa::cvtpk(p0[b8 + 2], p0[b8 + 3]); w.z = fa::cvtpk(p0[b8 + 4], p0[b8 + 5]); w.w = fa::cvtpk(p0[b8 + 6], p0[b8 + 7]); }
                else { const int b8 = 8 * (s - 2); w.x = fa::cvtpk(p1[b8], p1[b8 + 1]); w.y = fa::cvtpk(p1[b8 + 2], p1[b8 + 3]); w.z = fa::cvtpk(p1[b8 + 4], p1[b8 + 5]); w.w = fa::cvtpk(p1[b8 + 6], p1[b8 + 7]); }
                pf[s] = __builtin_bit_cast(bf16x8, w); }
_Pragma("unroll")
            for (int eh = 0; eh < 2; ++eh)
_Pragma("unroll")
                for (int s = 0; s < 4; ++s) { acc[eh][0] = __builtin_amdgcn_mfma_f32_32x32x16_bf16(v0[eh][s], pf[s], acc[eh][0], 0, 0, 0); acc[eh][1] = __builtin_amdgcn_mfma_f32_32x32x16_bf16(v1[eh][s], pf[s], acc[eh][1], 0, 0, 0); }
        }
    }
    { const float qd = exp2f((float)(n + 1) * lg2);
_Pragma("unroll")
      for (int eh = 0; eh < 2; ++eh)
_Pragma("unroll")
          for (int tl = 0; tl < 2; ++tl)
_Pragma("unroll")
              for (int r = 0; r < 16; ++r) acc[eh][tl][r] *= qd; }
    float s1 = 0.f;
_Pragma("unroll")
    for (int eh = 0; eh < 2; ++eh)
_Pragma("unroll")
        for (int tl = 0; tl < 2; ++tl)
_Pragma("unroll")
            for (int r = 0; r < 16; ++r) s1 += acc[eh][tl][r];
    const float mean = half_sum(s1) * (1.0f / 128.0f);
    float s2 = 0.f;
_Pragma("unroll")
    for (int eh = 0; eh < 2; ++eh)
_Pragma("unroll")
        for (int tl = 0; tl < 2; ++tl)
_Pragma("unroll")
            for (int r = 0; r < 16; ++r) { const float d = acc[eh][tl][r] - mean; s2 += d * d; }
    const float rs = 1.0f / sqrtf(half_sum(s2) * (1.0f / 128.0f) + NORM_EPS);
    const char* Gg = (const char*)(ws + B_RET) + (row0 + n) * 3072 + (1024 + h * 128) * 2;
    char* Og = (char*)(ws + B_OATT) + ((size_t)M + row0 + n) * 1024 + (h * 128) * 2;
_Pragma("unroll")
    for (int eh = 0; eh < 2; ++eh)
_Pragma("unroll")
        for (int tl = 0; tl < 2; ++tl)
_Pragma("unroll")
            for (int k4 = 0; k4 < 4; ++k4) { const int eo = (64 * eh + 32 * tl + 8 * k4 + 4 * hi) * 2;
                const v2u gw = *(const v2u*)(Gg + eo);
                const float y0 = pg8::siluf_(blo(gw.x)) * (acc[eh][tl][4 * k4] - mean) * rs, y1 = pg8::siluf_(bhi(gw.x)) * (acc[eh][tl][4 * k4 + 1] - mean) * rs,
                            y2 = pg8::siluf_(blo(gw.y)) * (acc[eh][tl][4 * k4 + 2] - mean) * rs, y3 = pg8::siluf_(bhi(gw.y)) * (acc[eh][tl][4 * k4 + 3] - mean) * rs;
                *(v2u*)(Og + eo) = (v2u){fa::cvtpk(y0, y1), fa::cvtpk(y2, y3)}; }
}

__global__ void __launch_bounds__(NWAVES * 64, 2) mk_fwd(Ptrs P) {
    extern __shared__ __attribute__((aligned(16))) unsigned char lds_raw[];
    LAS unsigned char* lds = (LAS unsigned char*)lds_raw;
    volatile LAS unsigned* MISC = (volatile LAS unsigned*)(lds + MISC_OFF);
    for (int u = threadIdx.x; u < (LDS_BYTES - LDSCTL_OFF) / 4; u += NWAVES * 64) ((LAS unsigned*)(lds + LDSCTL_OFF))[u] = 0u;
    const int wave_s = __builtin_amdgcn_readfirstlane((int)(threadIdx.x >> 6));
    __syncthreads();
    XcdBarrier bar = xcd_barrier_post((unsigned*)(P.ws + WS_CTL) + CW_BAR, MISC + 8);
#if MK_MULTI
    const int lo = P.ph_lo, hi = P.ph_hi;
#else
    constexpr int lo = 0, hi = 1 << 20;
#endif
    int ph = 0;
#define IN_PH() (lo <= ph && ph < hi)
#define END_PH() do { if (lo <= ph && ph + 1 < hi) { XcdBarrier b2_ = bar; asm volatile("" : "+s"(b2_.bar), "+s"(b2_.x)); b2_.bar = (unsigned*)(GAS unsigned*)b2_.bar; xcd_barrier(b2_); } ++ph; } while (0)
#define PH_LOCALS \
    unsigned ones_ = ~0u; int wave = wave_s; asm volatile("" : "+s"(ones_), "+s"(wave)); \
    const int lane = (int)__builtin_amdgcn_mbcnt_hi(ones_, __builtin_amdgcn_mbcnt_lo(ones_, 0u)); \
    const int tid = wave * 64 + lane; \
    const int G = gridDim.x; const int bx = blockIdx.x; const int vcu = (G % 8 == 0) ? (bx % 8) * (G / 8) + bx / 8 : bx; \
    const int NGW = G * NWAVES; \
    const int gw = vcu * NWAVES + wave; \
    const __attribute__((address_space(4))) Ptrs* kp = (const __attribute__((address_space(4))) Ptrs*)__builtin_amdgcn_kernarg_segment_ptr(); asm volatile("" : "+s"(kp)); \
    unsigned char* const ws = (unsigned char*)(GAS unsigned char*)kp->ws; float* const outp = (float*)(GAS float*)kp->out;     \
    gu32* const ctl = (gu32*)(ws + WS_CTL); \
    LAS float* const wscr = (LAS float*)(lds + wave * 16384); \
    (void)lane; (void)gw; (void)ctl; (void)wscr; (void)outp; (void)NGW; (void)bx;
#define PIN(i) ((const float*)(const GAS float*)kp->in[i])
#define mod ((float*)(ws + WS_MOD))
#define bias1 ((float*)(ws + WS_BIAS1))
#define ropetab ((f32x2*)(ws + WS_ROPE))
#define cum ((float*)(ws + WS_CUM))
#define CC ((bf16*)(ws + WS_CC))
#define HID ((bf16*)(ws + WS_HID))
#define SMALL ((float*)(ws + WS_SMALL))
#define Hb ((bf16*)(ws + WS_H))
#define NQ ((bf16*)(ws + B_NQ))
#define KV ((bf16*)(ws + B_KV))
#define RET ((bf16*)(ws + B_RET))
#define FOX ((bf16*)(ws + B_FOX))
#define MG ((bf16*)(ws + B_MG))
#define OATT ((bf16*)(ws + B_OATT))
#define MERGED ((bf16*)(ws + B_MERGED))
#define CMP ((bf16*)(ws + B_CMP))
#define RL ((float*)(ws + B_RL))
#define RS ((float*)(ws + B_RS))
#define HG ((bf16*)(ws + WS_HG))
#define SW ((float*)(ws + WS_SLOTW))

#define CONV_N_WIN ((1024 / 64) * (NPROJ / 64))
#define CONV_N_RD ((512 / 64) * (1024 / 64))
#define CONV_N_WO ((1024 / 64) * (1024 / 64))
#define CONV_N_C1 ((2048 / 64) * (256 / 64))
#define CONV_N_LAYER (CONV_N_WIN + 3 * CONV_N_RD + CONV_N_WO + 2 * CONV_N_C1)
#define CONV_N_F13 ((1024 / 64) * (2 * DFF / 64))
#define CONV_N_F2 ((DFF / 64) * (1024 / 64))
#define CONV_TOTAL (2 * CONV_N_LAYER + CONV_N_F13 + CONV_N_F2)
#define CONV_EARLY (CONV_N_WIN + 2 * CONV_N_C1)
#define CONV_LATE (CONV_TOTAL - CONV_EARLY)
#define CONV_ITEM_(IT_) do { int r = (IT_); \
                if (r < 2 * CONV_N_LAYER) { \
                    const int Lc = r / CONV_N_LAYER; r -= Lc * CONV_N_LAYER; \
                    if (r < CONV_N_WIN) { transpose_item<1>(PIN(I_WIN) + (size_t)Lc * D * DIN, nullptr, DIN, 1024, (bf16*)(ws + W_WIN) + (size_t)Lc * NPROJ * 1024, NPROJ, r, wscr, lane); break; } r -= CONV_N_WIN; \
                    if (r < 3 * CONV_N_RD) { const int q = r / CONV_N_RD; r -= q * CONV_N_RD; const float* w = (q == 0 ? PIN(I_RNSA) : q == 1 ? PIN(I_RRET) : PIN(I_RFOX)) + (size_t)Lc * 512 * 1024; \
                        transpose_item<0>(w, nullptr, 1024, 512, (bf16*)(ws + W_READ) + (size_t)(Lc * 3 + q) * 1024 * 512, 1024, r, wscr, lane); break; } r -= 3 * CONV_N_RD; \
                    if (r < CONV_N_WO) { transpose_item<0>(PIN(I_WOUT) + (size_t)Lc * 1024 * 1024, nullptr, 1024, 1024, (bf16*)(ws + W_OUT) + (size_t)Lc * 1024 * 1024, 1024, r, wscr, lane); break; } r -= CONV_N_WO; \
                    const int kv = r / CONV_N_C1; r -= kv * CONV_N_C1; \
                    transpose_item<0>((kv ? PIN(I_CVW1) : PIN(I_CKW1)) + (size_t)Lc * 2048 * 256, nullptr, 256, 2048, (bf16*)(ws + W_C1) + (size_t)(Lc * 2 + kv) * 256 * 2048, 256, r, wscr, lane); break; \
                } \
                r -= 2 * CONV_N_LAYER; \
                if (r < CONV_N_F13) { transpose_item<2>(PIN(I_FW1), PIN(I_FW3), DFF, 1024, (bf16*)(ws + W_F13), 2 * DFF, r, wscr, lane); break; } r -= CONV_N_F13; \
                transpose_item<0>(PIN(I_FW2), nullptr, 1024, DFF, (bf16*)(ws + W_F2), 1024, r, wscr, lane); } while (0)
    if (IN_PH()) { PH_LOCALS
        {
#pragma unroll 1
            for (int j = gw; j < CONV_EARLY; j += NGW) { const int it = (j < CONV_N_WIN) ? j : j + (CONV_N_LAYER - CONV_N_WIN - 2 * CONV_N_C1); CONV_ITEM_(it); }
        }
        {
            LAS float* red = (LAS float*)(lds + 8 * 16384 - 4096);
            __syncthreads();
            for (int u = vcu; u < 2 * 96; u += G) {
                const int L = u / 96, j0 = (u % 96) * 64;
                const float* aw = PIN(I_ADAW) + (size_t)L * 1024 * 6144 + j0 + lane; const float* c0 = PIN(I_C), * c1 = PIN(I_C) + 1024;
                float s0 = 0.f, s1 = 0.f;
#pragma unroll 8
                for (int k = wave * 128; k < wave * 128 + 128; ++k) { const float w = aw[(size_t)k * 6144]; const float a0 = c0[k], a1 = c1[k];
                    s0 += (a0 / (1.f + __expf(-a0))) * w; s1 += (a1 / (1.f + __expf(-a1))) * w; }
                red[(wave * 2 + 0) * 64 + lane] = s0; red[(wave * 2 + 1) * 64 + lane] = s1;
                __syncthreads();
                if (wave < 2) { float s = 0.f;
#pragma unroll
                    for (int w = 0; w < 8; ++w) s += red[(w * 2 + wave) * 64 + lane];
                    mod[(size_t)(L * 2 + wave) * 6144 + j0 + lane] = s + PIN(I_ADAB)[L * 6144 + j0 + lane]; }
                __syncthreads();
            }
        }
        for (int idx = gw * 64 + lane; idx < T * 32; idx += NGW * 64) {
            const int t = idx >> 5, i = idx & 31;
            const double inv = exp(-((double)i / 32.0) * 9.210340371976184);
            const double ang = (double)t * inv; double sn, cs; sincos(ang, &sn, &cs);
            ropetab[idx] = (f32x2){(float)cs, (float)sn};
        }
    }
    END_PH();

#pragma unroll 1
    for (int L = 0; L < 2; ++L) {
        if (IN_PH()) { PH_LOCALS
            const float* gam = PIN(I_NMIX) + L * 1024;
#define NORM1_ROWS_(X32) { \
            v4u rn[4]; \
            _Pragma("unroll") for (int q = 0; q < 4; ++q) { if (X32) rn[q] = ((const GAS v4u*)(PIN(I_X) + (size_t)gw * D) + lane)[64 * q]; else { const v2u w_ = ((const GAS v2u*)((const bf16*)(ws + WS_XR) + (size_t)gw * D) + lane)[64 * q]; rn[q].x = w_.x; rn[q].y = w_.y; } } \
            int m = gw; \
            _Pragma("unroll 1") for (int b = 0; b < M / T; ++b) { \
              f32x4 A4[4], S4[4], B4[4]; \
              { const float* sh = (mod + (size_t)L * 2 * 6144) + b * 6144, * sc = sh + 1024; \
                _Pragma("unroll") for (int q = 0; q < 4; ++q) { const int c = 256 * q + 4 * lane; A4[q] = *(const f32x4*)(gam + c); S4[q] = *(const f32x4*)(sc + c) + 1.0f; B4[q] = *(const f32x4*)(sh + c); } } \
              _Pragma("unroll 1") for (; m < (b + 1) * T; m += NGW) { \
                f32x4 v[4]; float ss = 0.f; \
                _Pragma("unroll") for (int q = 0; q < 4; ++q) { if (X32) v[q] = (f32x4){__uint_as_float(rn[q].x), __uint_as_float(rn[q].y), __uint_as_float(rn[q].z), __uint_as_float(rn[q].w)}; \
                                                                else v[q] = (f32x4){blo(rn[q].x), bhi(rn[q].x), blo(rn[q].y), bhi(rn[q].y)}; } \
                { const int mn = (m + NGW < M) ? m + NGW : m; \
                  _Pragma("unroll") for (int q = 0; q < 4; ++q) { if (X32) rn[q] = ((const GAS v4u*)(PIN(I_X) + (size_t)mn * D) + lane)[64 * q]; else { const v2u w_ = ((const GAS v2u*)((const bf16*)(ws + WS_XR) + (size_t)mn * D) + lane)[64 * q]; rn[q].x = w_.x; rn[q].y = w_.y; } } } \
                _Pragma("unroll") for (int q = 0; q < 4; ++q) ss += (v[q].x * v[q].x + v[q].y * v[q].y) + (v[q].z * v[q].z + v[q].w * v[q].w); \
                const float rstd = 1.0f / sqrtf(wave_sum(ss) * (1.f / D) + NORM_EPS); \
                GAS v2u* o8 = (GAS v2u*)(Hb + (size_t)m * D) + lane; \
                _Pragma("unroll") for (int q = 0; q < 4; ++q) { const f32x4 y = v[q] * rstd * A4[q] * S4[q] + B4[q]; o8[64 * q] = (v2u){pk2(y.x, y.y), pk2(y.z, y.w)}; } \
              } } }
            if (L == 0) NORM1_ROWS_(true) else NORM1_ROWS_(false)
#undef NORM1_ROWS_
        }
        END_PH();
        if (IN_PH()) { PH_LOCALS
            pg8::Gemm g{Hb, (const bf16*)(ws + W_WIN) + (size_t)L * NPROJ * 1024, 1024, 1024, 1024}; pg8::StaticOrder S; S.init(M, NPROJ, G, bx);
            pg8::EpiProj E{ws, (unsigned)B_NQ, (unsigned)B_KV, (unsigned)B_RET, (unsigned)B_FOX, (unsigned)B_MG, (unsigned)WS_SMALL};
#pragma unroll 1
            for (int rep_ = 0; rep_ < REP_PROJ; ++rep_) pg8::gemm_phase<pg8::EpiProj, pg8::StaticOrder, true>(lds, g, S, E, tid);
            if (L == 0 && bx >= G / 2) {
                int lane_h = lane, wave_h = wave; asm volatile("" : "+v"(lane_h), "+s"(wave_h));
                const int hgw_ = (bx - G / 2) * NWAVES + wave_h, hn_ = (G - G / 2) * NWAVES;
            for (int idx = hgw_; idx < 2 * 2 * 256; idx += hn_) {
                const int Lq = idx >> 9, kv = (idx >> 8) & 1, j = idx & 255;
                const float* pe = PIN(kv ? I_CVPE : I_CKPE) + (size_t)Lq * 2048; const float* w1 = PIN(kv ? I_CVW1 : I_CKW1) + (size_t)Lq * 2048 * 256 + j;
                float s = 0.f;
#pragma unroll 8
                for (int r = lane_h; r < 2048; r += 64) s += pe[r] * w1[(size_t)r * 256];
                s = wave_sum(s);
                if (lane_h == 0) bias1[idx] = s;
            }
            }
        }
        END_PH();
        if (IN_PH()) { PH_LOCALS
            { float km0 = 0.f, km1 = 0.f, kmn = 0.f;
              const int hh = lane >> 3, i0 = (lane & 7) * 4;
#pragma unroll 1
              for (int m = gw; m < M; m += NGW) {
                const int b = m >> 13, t = m & (T - 1);
                const f32x2* cs = ropetab + t * 32;
                f32x2 cv[4];
#pragma unroll
                for (int q = 0; q < 4; ++q) cv[q] = cs[i0 + q];
                bf16* pq = NQ + (size_t)m * 512 + hh * 64 + i0;
                const bool isk = lane < 48; const int which = hh >> 1, gg = hh & 1; const int q48 = lane - 48;
                const bf16* pk = isk ? (KV + (size_t)m * 768 + which * 256 + gg * 64 + i0) : (KV + (size_t)m * 768 + 128 + (q48 >> 3) * 64 + (q48 & 7) * 8);
                const int koff2 = isk ? 32 : 4;
                bf16* pr = RET + (size_t)m * 1536 + hh * 64 + i0;
                const v2u qa = *(const v2u*)pq, qc = *(const v2u*)(pq + 32);
                const v2u ka = *(const v2u*)pk, kc = *(const v2u*)(pk + koff2);
                const v2u ra = *(const v2u*)pr, rc = *(const v2u*)(pr + 32);
                const v4u fw = *(const v4u*)((const char*)(FOX + (size_t)m * 1536 + 512) + (size_t)(unsigned)(lane * 16));
                { const float x1[4] = {blo(qa.x), bhi(qa.x), blo(qa.y), bhi(qa.y)}, x2[4] = {blo(qc.x), bhi(qc.x), blo(qc.y), bhi(qc.y)}; float y1[4], y2[4];
#pragma unroll
                  for (int q = 0; q < 4; ++q) { y1[q] = (x1[q] * cv[q].x - x2[q] * cv[q].y) * fa::C2; y2[q] = (x2[q] * cv[q].x + x1[q] * cv[q].y) * fa::C2; }
                  *(v2u*)pq = (v2u){pk2(y1[0], y1[1]), pk2(y1[2], y1[3])}; *(v2u*)(pq + 32) = (v2u){pk2(y2[0], y2[1]), pk2(y2[2], y2[3])}; }
                { const float x1[4] = {blo(ka.x), bhi(ka.x), blo(ka.y), bhi(ka.y)}, x2[4] = {blo(kc.x), bhi(kc.x), blo(kc.y), bhi(kc.y)}; float y1[4], y2[4];
#pragma unroll
                  for (int q = 0; q < 4; ++q) { y1[q] = x1[q] * cv[q].x - x2[q] * cv[q].y; y2[q] = x2[q] * cv[q].x + x1[q] * cv[q].y; }
                  bf16* d = !isk ? (CMP + ((size_t)(4 + b * 2 + (q48 >> 3)) * T + t) * 64 + (q48 & 7) * 8)
                          : (which == 0) ? (CMP + ((size_t)(b * 2 + gg) * T + t) * 64 + i0) : (KV + (size_t)m * 768 + which * 256 + gg * 64 + i0);
                  const v2u o1 = isk ? (v2u){pk2(y1[0], y1[1]), pk2(y1[2], y1[3])} : ka, o2 = isk ? (v2u){pk2(y2[0], y2[1]), pk2(y2[2], y2[3])} : kc;
                  *(v2u*)d = o1; *(v2u*)(d + koff2) = o2;
                  float s = (y1[0] * y1[0] + y1[1] * y1[1]) + (y1[2] * y1[2] + y1[3] * y1[3]) + (y2[0] * y2[0] + y2[1] * y2[1]) + (y2[2] * y2[2] + y2[3] * y2[3]);
                  s += dpp_f<0xB1>(s); s += dpp_f<0x4E>(s); s += dpp_f<0x141>(s);
                  if (isk && which != 0) kmn = fmaxf(kmn, s); }
                { const float sc8 = (hh >= 4) ? 0.125f : 1.0f;
                  const float x1[4] = {blo(ra.x), bhi(ra.x), blo(ra.y), bhi(ra.y)}, x2[4] = {blo(rc.x), bhi(rc.x), blo(rc.y), bhi(rc.y)}; float y1[4], y2[4];
#pragma unroll
                  for (int q = 0; q < 4; ++q) { y1[q] = (x1[q] * cv[q].x - x2[q] * cv[q].y) * sc8; y2[q] = (x2[q] * cv[q].x + x1[q] * cv[q].y) * sc8; }
                  *(v2u*)pr = (v2u){pk2(y1[0], y1[1]), pk2(y1[2], y1[3])}; *(v2u*)(pr + 32) = (v2u){pk2(y2[0], y2[1]), pk2(y2[2], y2[3])}; }
                { float s = blo(fw.x) * blo(fw.x) + bhi(fw.x) * bhi(fw.x) + blo(fw.y) * blo(fw.y) + bhi(fw.y) * bhi(fw.y) + blo(fw.z) * blo(fw.z) + bhi(fw.z) * bhi(fw.z) + blo(fw.w) * blo(fw.w) + bhi(fw.w) * bhi(fw.w);
                  s += dpp_f<0xB1>(s); s += dpp_f<0x4E>(s); s += dpp_f<0x141>(s);
                  if (m < T) km0 = fmaxf(km0, s); else km1 = fmaxf(km1, s); }
              }
              LAS unsigned* kml = (LAS unsigned*)(lds + MISC_OFF + 192); LAS unsigned* kmnl = (LAS unsigned*)(lds + MISC_OFF + 128);
              if (tid < 16) kml[tid] = 0u;
              if (tid == 16) kmnl[0] = 0u;
              __syncthreads();
              if ((lane & 7) == 0) { atomicMax((unsigned*)(kml + (lane >> 3)), __float_as_uint(km0)); atomicMax((unsigned*)(kml + 8 + (lane >> 3)), __float_as_uint(km1)); atomicMax((unsigned*)kmnl, __float_as_uint(kmn)); }
              __syncthreads();
              if (tid < 16) { const unsigned v = kml[tid]; gu32* gp = ctl + CW_KMAX + 32 * L + tid; if (v > __hip_atomic_load(gp, RLX_AGENT)) atomicMax((unsigned*)gp, v); }
              if (tid == 16) { const unsigned v = kmnl[0]; gu32* gp = ctl + CW_KMAX + 32 * L + 16; if (v > __hip_atomic_load(gp, RLX_AGENT)) atomicMax((unsigned*)gp, v); }
            }
            if (gw == NGW - 1) { unsigned z_ = 0u; asm volatile("" : "+v"(z_)); for (int i = lane; i < 1024 / 8; i += 64) *(v4u*)(CMP + (size_t)8 * T * 64 + i * 8) = (v4u){z_, z_, z_, z_}; }
            if (vcu < 16) {
                __syncthreads();
                const int bh = vcu, b = bh >> 3, h = bh & 7; const float fb = PIN(I_FBIAS)[L * 8 + h];
                const float* srcp = SMALL + ((size_t)b * T + tid * 16) * 32 + 24 + h;
                float ls[16];
#pragma unroll
                for (int i = 0; i < 16; ++i) { const float x = srcp[(size_t)i * 32] + fb; ls[i] = fminf(x, 0.f) - __logf(1.0f + __expf(-fabsf(x))); }
                double tot = 0.0;
#pragma unroll
                for (int i = 0; i < 16; ++i) tot += (double)ls[i];
                LAS double* sd = (LAS double*)lds; sd[tid] = tot;
                __syncthreads();
                double off = 0.0;
                for (int i = 0; i < tid; ++i) off += sd[i];
                float* dst = cum + (size_t)bh * T + tid * 16;
#pragma unroll
                for (int i = 0; i < 16; ++i) { off += (double)ls[i]; dst[i] = (float)off; }
                __syncthreads();
            }
        }
        END_PH();
        if (IN_PH()) { PH_LOCALS
            {
                const int ks = (bx >> 4) & 3;
                pg8::Gemm g{CMP + ks * 512, (const bf16*)(ws + W_C1) + (size_t)L * 2 * 256 * 2048 + ks * 512, 1024, 2048, 512}; pg8::CmpOrder S{G, bx};
                pg8::EpiPart E{(float*)(ws + B_PART) + (size_t)ks * 4096 * 256};
                pg8::gemm_phase<pg8::EpiPart, pg8::CmpOrder, true>(lds, g, S, E, tid);
            }
            { const int r32 = lane & 31, hi = lane >> 5;
              fa::bf16x8 E0, E1;
#pragma unroll
              for (int j = 0; j < 8; ++j) { E0[j] = (r32 == 8 * hi + j) ? (short)0x3F80 : (short)0; E1[j] = (r32 == 16 + 8 * hi + j) ? (short)0x3F80 : (short)0; }
              const bool gemm_wg = (G > 64) && (bx < 64); const int tw_ = gemm_wg ? 0 : ((G > 64) ? (bx - 64) * NWAVES + wave : gw), tn_ = (G > 64) ? (G - 64) * NWAVES : NGW;
#pragma unroll 1
              for (int u = gemm_wg ? 48 * 128 : 24 * 128 + tw_; u < 48 * 128; u += tn_) {
                const int which = u >> 7, tb = u & 127; const bf16* sp; bf16* dp; int pitch = 1536; float lg2 = 0.f;
                if (which < 16) { sp = FOX + ((size_t)(which >> 3) * T + tb * 64) * 1536 + 1024 + (which & 7) * 64; dp = (bf16*)(ws + B_FVT) + (size_t)which * 64 * T; }
                else if (which < 20) { const int bg2 = which - 16; sp = KV + ((size_t)(bg2 >> 1) * T + tb * 64) * 768 + 384 + (bg2 & 1) * 64; dp = (bf16*)(ws + B_SVT) + (size_t)bg2 * 64 * T; pitch = 768; }
                else if (which < 24) { const int bg2 = which - 20; sp = KV + ((size_t)(bg2 >> 1) * T + tb * 64) * 768 + 640 + (bg2 & 1) * 64; dp = (bf16*)(ws + B_WVT) + (size_t)bg2 * 64 * T; pitch = 768; }
                else if (which < 40) { const int j2 = which - 24, bh = j2 >> 1, eh = j2 & 1; sp = RET + ((size_t)(bh >> 2) * T + tb * 64) * 1536 + 512 + (bh & 3) * 128 + eh * 64; dp = (bf16*)(ws + B_RVT) + (size_t)(bh * 128 + eh * 64) * T;
                    lg2 = log2f(1.0f - exp2f(-5.0f - (float)(bh & 3))); }
                else { const int bh = which - 40; sp = RET + ((size_t)(bh >> 2) * T + tb * 64) * 1536 + 256 + (bh & 3) * 64; dp = (bf16*)(ws + B_RKT) + (size_t)bh * 64 * T; }
                const bool dec = (which >= 24 && which < 40); const int tm0 = 127 - (tb & 1) * 64;
                const char* sb = (const char*)sp; asm volatile("" : "+s"(sb));
                const unsigned lo_ = (unsigned)(r32 * pitch * 2 + hi * 16);
                fa::bf16x8 af[2][4];
#pragma unroll
                for (int rt = 0; rt < 2; ++rt)
#pragma unroll
                    for (int c16 = 0; c16 < 4; ++c16) af[rt][c16] = *(const GAS fa::bf16x8*)((const GAS char*)sb + (size_t)(unsigned)(rt * 32 * pitch * 2) + (size_t)lo_ + c16 * 32);
                char* db = (char*)(dp + tb * 64); asm volatile("" : "+s"(db));
                const unsigned so_ = (unsigned)(r32 * T * 2 + hi * 16);
#pragma unroll
                for (int rt = 0; rt < 2; ++rt)
#pragma unroll
                    for (int ct = 0; ct < 2; ++ct) {
                        fa::f32x16 dacc;
#pragma unroll
                        for (int r = 0; r < 16; ++r) dacc[r] = 0.f;
                        dacc = __builtin_amdgcn_mfma_f32_32x32x16_bf16(af[rt][2 * ct], E0, dacc, 0, 0, 0);
                        dacc = __builtin_amdgcn_mfma_f32_32x32x16_bf16(af[rt][2 * ct + 1], E1, dacc, 0, 0, 0);
                        if (dec) {
#pragma unroll
                            for (int r = 0; r < 16; ++r) dacc[r] *= exp2f((float)(tm0 - 32 * rt - CR(r) - 4 * hi) * lg2); }
#pragma unroll
                        for (int g2_ = 0; g2_ < 2; ++g2_) { const int b8 = 8 * g2_;
                            const v4u w = {fa::cvtpk(dacc[b8], dacc[b8 + 1]), fa::cvtpk(dacc[b8 + 2], dacc[b8 + 3]), fa::cvtpk(dacc[b8 + 4], dacc[b8 + 5]), fa::cvtpk(dacc[b8 + 6], dacc[b8 + 7])};
                            *(GAS v4u*)((GAS char*)db + (size_t)(unsigned)(ct * 32 * T * 2) + (size_t)so_ + (32 * rt + 16 * g2_) * 2) = w; }
                    }
              }
            }
        }
        END_PH();
        if (IN_PH()) { PH_LOCALS
            { LAS float* w2s = (LAS float*)lds; LAS float* hs = (LAS float*)(lds + 65536 + wave * 1024);
              float kmc = 0.f;
              LAS unsigned* kmnl = (LAS unsigned*)(lds + MISC_OFF + 128);
              if (tid == 0) kmnl[0] = 0u;
#pragma unroll 1
              for (int kv = 0; kv < 2; ++kv) {
                __syncthreads();
                { const float* w2 = PIN(kv ? I_CVW2 : I_CKW2) + (size_t)L * 256 * 64;
#pragma unroll
                  for (int i = 0; i < 8; ++i) *(LAS f32x4*)(w2s + (i * 512 + tid) * 4) = *(const f32x4*)(w2 + (i * 512 + tid) * 4); }
                __syncthreads();
                const float* b1 = bias1 + L * 512 + kv * 256 + 4 * lane;
#pragma unroll 1
                for (int r = gw; r < 2048; r += NGW) { const int row = kv * 2048 + r;
                    const float* pp = (const float*)(ws + B_PART) + (size_t)row * 256 + 4 * lane;
                    f32x4 h = *(const f32x4*)b1;
#pragma unroll
                    for (int s4 = 0; s4 < 4; ++s4) h += *(const f32x4*)(pp + (size_t)s4 * 4096 * 256);
                    h.x = pg8::siluf_(h.x); h.y = pg8::siluf_(h.y); h.z = pg8::siluf_(h.z); h.w = pg8::siluf_(h.w);
                    WAVE_SYNC(); *(LAS f32x4*)(hs + 4 * lane) = h; WAVE_SYNC();
                    float s = 0.f;
#pragma unroll 8
                    for (int j = 0; j < 256; j += 4) { const f32x4 hv = *(const LAS f32x4*)(hs + j);
                        s += hv.x * w2s[(j + 0) * 64 + lane] + hv.y * w2s[(j + 1) * 64 + lane] + hv.z * w2s[(j + 2) * 64 + lane] + hv.w * w2s[(j + 3) * 64 + lane]; }
                    if (kv == 0) { const bf16 sb_ = (bf16)f2bf(s); CC[(size_t)row * 64 + lane] = sb_; const float sr = bf2f(sb_); kmc = fmaxf(kmc, wave_sum(sr * sr)); }
                    else { const int bgn = row - 2048; ((bf16*)(ws + WS_CCVT))[(size_t)bgn * 64 + lane] = (bf16)f2bf(s); }
                }
              }
              if (lane == 0) atomicMax((unsigned*)kmnl, __float_as_uint(kmc));
              __syncthreads();
              if (tid == 0) { const unsigned v = kmnl[0]; gu32* gp = ctl + CW_KMAX + 32 * L + 16; if (v > __hip_atomic_load(gp, RLX_AGENT)) atomicMax((unsigned*)gp, v); }
            }
            { const int r32 = lane & 31, hi = lane >> 5, et = wave & 3, dt = wave >> 2;
#pragma unroll 1
              for (int u = vcu; u < 512; u += G) { const int bh = u >> 6, c = u & 63;
                const char* va = (const char*)(ws + B_RVT) + ((size_t)(bh * 128 + 32 * et + r32) * T + c * 128 + 8 * hi) * 2;
                const char* kb2 = (const char*)(ws + B_RKT) + ((size_t)(bh * 64 + 32 * dt + r32) * T + c * 128 + 8 * hi) * 2;
                fa::f32x16 acc;
#pragma unroll
                for (int r = 0; r < 16; ++r) acc[r] = 0.f;
                fa::bf16x8 af[8], bf[8];
#pragma unroll
                for (int s = 0; s < 8; ++s) { af[s] = *(const fa::bf16x8*)(va + 32 * s); bf[s] = *(const fa::bf16x8*)(kb2 + 32 * s); }
#pragma unroll
                for (int s = 0; s < 8; ++s) acc = __builtin_amdgcn_mfma_f32_32x32x16_bf16(af[s], bf[s], acc, 0, 0, 0);
                float* dst = RL + (size_t)u * 8192 + (size_t)(32 * et + 4 * hi) * 64 + 32 * dt + r32;
#pragma unroll
                for (int r = 0; r < 16; ++r) dst[(size_t)CR(r) * 64] = acc[r];
              }
            }
            if (L == 0) {
                __syncthreads();
#pragma unroll 1
                for (int j = gw; j < CONV_LATE; j += NGW) { const int it = (j < CONV_N_LAYER - CONV_EARLY) ? CONV_N_WIN + j : j + CONV_EARLY; CONV_ITEM_(it); }
            }
        }
        END_PH();
        if (IN_PH()) {
          { PH_LOCALS
            if (wave < 4) {
#pragma unroll 1
              for (int idx = vcu * 256 + tid; idx < 8 * 8192; idx += G * 256) {
                const int bh = idx >> 13, ed = idx & 8191, h = bh & 3;
                const float cd = exp2f(128.0f * log2f(1.0f - exp2f(-5.0f - (float)h)));
                float s = 0.f; const float* srcp = RL + (size_t)bh * 64 * 8192 + ed; bf16* dst = (bf16*)(ws + B_RS) + (size_t)bh * 64 * 8192 + ed;
                float x[64];
#pragma unroll
                for (int c = 0; c < 64; ++c) x[c] = ((const GAS float*)srcp)[(size_t)c * 8192];
                GAS unsigned* dw = (GAS unsigned*)((GAS bf16*)dst - (lane & 1));
#pragma unroll
                for (int c = 0; c < 64; ++c) { const unsigned my = f2bf(s); const unsigned nb = (unsigned)dpp_i<0xB1>((int)my);
                    const unsigned wd = (lane & 1) ? (nb | (my << 16)) : (my | (nb << 16));
                    if ((c & 1) == (lane & 1)) __hip_atomic_store((unsigned*)(dw + (size_t)c * 4096), wd, __ATOMIC_RELAXED, __HIP_MEMORY_SCOPE_AGENT);
                    s = s * cd + x[c]; }
              }
              asm volatile("s_waitcnt vmcnt(0)" ::: "memory");
            }
            __syncthreads();
            if (tid == 0) __hip_atomic_fetch_add((unsigned*)(ctl + CW_SCAN + 64 * L), 1u, __ATOMIC_RELAXED, __HIP_MEMORY_SCOPE_AGENT);
          }
          { PH_LOCALS
#pragma unroll 1
            for (int rep_ = 0; rep_ < REP_FOX; ++rep_)
#pragma unroll 1
            for (int u2 = 2 * vcu; u2 < 512; u2 += 2 * G) {
#pragma unroll 1
                for (int k = 0; k < 2; ++k) { const int u = u2 >> 1, bh = u >> 4, s = u & 15; fox_unit(lds, ws, L, bh >> 3, bh & 7, k ? s : 31 - s, tid, wave, lane); } }
          }
          { PH_LOCALS
#pragma unroll 1
            for (int rep_ = 0; rep_ < REP_NSA; ++rep_)
#pragma unroll 1
            for (int u2 = 2 * vcu; u2 < 512; u2 += 2 * G) {
#pragma unroll 1
                for (int k = 0; k < 2; ++k) { const int u = u2 >> 1, bg2 = u >> 6, s = u & 63; nsa_unit(lds, ws, L, bg2 >> 1, bg2 & 1, k ? s : 127 - s, tid, wave, lane); } }
            __syncthreads();
          }
          { PH_LOCALS
            if (wave == 0) { unsigned sp_ = 0u;
                while ((unsigned)__builtin_amdgcn_readfirstlane(__hip_atomic_load((unsigned*)(ctl + CW_SCAN + 64 * L), __ATOMIC_RELAXED, __HIP_MEMORY_SCOPE_AGENT)) < (unsigned)G && ++sp_ < (1u << 22)) __builtin_amdgcn_s_sleep(2);
                __builtin_amdgcn_fence(__ATOMIC_ACQUIRE, "agent"); asm volatile("s_waitcnt vmcnt(0)" ::: "memory"); }
            __syncthreads();
#pragma unroll 1
            for (int rep_ = 0; rep_ < REP_RET; ++rep_)
#pragma unroll 1
            for (int u = 2 * vcu + (wave >> 2); u < 512; u += 2 * G) ret_unit(ws, u >> 6, u & 63, wave & 3, lane);
          }
        }
        END_PH();
        if (IN_PH()) { PH_LOCALS
            pg8::MergeOrder S; S.so.init(M, 1024, G, bx);
            pg8::Gemm g{OATT, (const bf16*)(ws + W_READ) + (size_t)L * 3 * 1024 * 512, 512, 512, 512}; pg8::EpiMergeC E{MG, MERGED};
            pg8::gemm_phase_chain<pg8::EpiMergeC, pg8::MergeOrder, true>(lds, g, S, E, tid);
        }
        END_PH();
        if (IN_PH()) { PH_LOCALS
            pg8::Gemm g{MERGED, (const bf16*)(ws + W_OUT) + (size_t)L * 1024 * 1024, 1024, 1024, 1024}; pg8::StaticOrder S; S.init(M, 1024, G, bx);
            bf16* XR = (bf16*)(ws + WS_XR);
            if (L == 0) { pg8::EpiResid<true> E{PIN(I_X), nullptr, XR, (mod + (size_t)L * 2 * 6144) + 2 * 1024, 6144};
                pg8::gemm_phase<pg8::EpiResid<true>, pg8::StaticOrder, true>(lds, g, S, E, tid); }
            else { pg8::EpiResid<false> E{nullptr, XR, XR, (mod + (size_t)L * 2 * 6144) + 2 * 1024, 6144};
                pg8::gemm_phase<pg8::EpiResid<false>, pg8::StaticOrder, true>(lds, g, S, E, tid); }
        }
        END_PH();
        if (IN_PH()) { PH_LOCALS
            const float* gam = PIN(I_NFFN) + L * 1024;
            LAS f32x4* rwl = (LAS f32x4*)lds;
            if (L == 1) { if (tid < 8) ((LAS unsigned*)(lds + MISC_OFF + 128))[tid] = 0u;
#pragma unroll
                for (int k = 0; k < 4; ++k) { const int idx = tid + 512 * k, ln = idx & 63, r = idx >> 6, half = r & 1, e4 = (r >> 1) & 3, q = r >> 3;
                    rwl[idx] = *(const f32x4*)(PIN(I_ROUTER) + (size_t)(256 * q + 4 * ln + e4) * 8 + 4 * half); }
                __syncthreads(); }
            int m = gw;
            v2u wn[4];
            { const GAS v2u* xr_ = (const GAS v2u*)((const bf16*)(ws + WS_XR) + (size_t)m * D) + lane;
#pragma unroll
              for (int q = 0; q < 4; ++q) wn[q] = xr_[64 * q]; }
_Pragma("unroll 1")
            for (int b = 0; b < M / T; ++b) {
              f32x4 A4[4], S4[4], B4[4];
              { const float* sh = (mod + (size_t)L * 2 * 6144) + b * 6144 + 3 * 1024, * sc = sh + 1024;
#pragma unroll
                for (int q = 0; q < 4; ++q) { const int c = 256 * q + 4 * lane; A4[q] = *(const f32x4*)(gam + c); S4[q] = *(const f32x4*)(sc + c) + 1.0f; B4[q] = *(const f32x4*)(sh + c); } }
_Pragma("unroll 1")
              for (; m < (b + 1) * T; m += NGW) {
                f32x4 v[4]; float ss = 0.f;
#pragma unroll
                for (int q = 0; q < 4; ++q) { const v2u w = wn[q]; v[q] = (f32x4){blo(w.x), bhi(w.x), blo(w.y), bhi(w.y)}; ss += (v[q].x * v[q].x + v[q].y * v[q].y) + (v[q].z * v[q].z + v[q].w * v[q].w); }
                { const int mn = (m + NGW < M) ? m + NGW : m; const GAS v2u* xr_ = (const GAS v2u*)((const bf16*)(ws + WS_XR) + (size_t)mn * D) + lane;
#pragma unroll
                  for (int q = 0; q < 4; ++q) wn[q] = xr_[64 * q]; }
                const float rstd = 1.0f / sqrtf(wave_sum(ss) * (1.f / D) + NORM_EPS);
                GAS v2u* o8 = (GAS v2u*)(Hb + (size_t)m * D) + lane;
                float lg[8] = {};
#pragma unroll
                for (int q = 0; q < 4; ++q) { const f32x4 y = v[q] * rstd * A4[q] * S4[q] + B4[q]; o8[64 * q] = (v2u){pk2(y.x, y.y), pk2(y.z, y.w)};
                    if (L == 1) {
#pragma unroll
                        for (int e4 = 0; e4 < 4; ++e4) { const f32x4 w0 = rwl[((q * 4 + e4) * 2 + 0) * 64 + lane], w1 = rwl[((q * 4 + e4) * 2 + 1) * 64 + lane]; const float yy = y[e4];
                            lg[0] += yy * w0.x; lg[1] += yy * w0.y; lg[2] += yy * w0.z; lg[3] += yy * w0.w; lg[4] += yy * w1.x; lg[5] += yy * w1.y; lg[6] += yy * w1.z; lg[7] += yy * w1.w; } }
                }
                if (L == 1) {
#pragma unroll
                    for (int e = 0; e < 8; ++e) lg[e] = wave_sum(lg[e]);
                    int e0 = 0; float v0 = lg[0];
#pragma unroll
                    for (int e = 1; e < 8; ++e) if (lg[e] > v0) { v0 = lg[e]; e0 = e; }
                    int e1 = -1; float v1 = -INFINITY;
#pragma unroll
                    for (int e = 0; e < 8; ++e) if (e != e0 && lg[e] > v1) { v1 = lg[e]; e1 = e; }
                    const float w1 = 1.0f / (1.0f + __expf(v0 - v1)), w0 = 1.0f - w1;
                    if (lane == 0) {
                        LAS unsigned* lcnt = (LAS unsigned*)(lds + MISC_OFF + 128);
                        const unsigned r0 = atomicAdd((unsigned*)(lcnt + e0), 1u), r1 = atomicAdd((unsigned*)(lcnt + e1), 1u);
                        int* ti = (int*)(ws + WS_TOKINFO) + (size_t)m * 8;
                        ti[0] = e0; ti[1] = (int)r0; ti[2] = e1; ti[3] = (int)r1; ((float*)ti)[4] = w0; ((float*)ti)[5] = w1;
                    }
                }
              }
            }
            if (L == 1) {
                __syncthreads();
                if (tid < 8) { const unsigned n_ = ((LAS unsigned*)(lds + MISC_OFF + 128))[tid];
                    ((int*)(ws + WS_BBASE))[vcu * 8 + tid] = (int)__hip_atomic_fetch_add((unsigned*)(ctl + CW_ECNT + 64 * tid), n_, RLX_AGENT); }
            }
            if (L == 1) {
                const int n13 = tj_items(1024, 2 * DFE), n2 = tj_items(DFE, 1024);
#pragma unroll 1
                for (int rep_ = 0; rep_ < REP_CONV; ++rep_)
#pragma unroll 1
                for (int it = gw; it < NEXP * (n13 + n2); it += NGW) {
                    const int e = it / (n13 + n2); int r = it - e * (n13 + n2);
                    if (r < n13) { transpose_item<2>(PIN(I_MW1) + (size_t)e * D * DFE, PIN(I_MW3) + (size_t)e * D * DFE, DFE, 1024, (bf16*)(ws + B_MW13) + (size_t)e * 2 * DFE * 1024, 2 * DFE, r, wscr, lane); continue; }
                    r -= n13; transpose_item<0>(PIN(I_MW2) + (size_t)e * DFE * D, nullptr, 1024, DFE, (bf16*)(ws + B_MW2) + (size_t)e * 1024 * DFE, 1024, r, wscr, lane);
                }
            }
        }
        END_PH();
        if (L == 0) {
            if (IN_PH()) { PH_LOCALS
                pg8::Gemm g{Hb, (const bf16*)(ws + W_F13), 1024, 1024, 1024}; pg8::StaticOrder S; S.init(M, 2 * DFF, G, bx);
                pg8::EpiSwiglu E{(bf16*)(ws + B_ACT0), DFF, 1 << 20};
                _Pragma("unroll 1") for (int rep_ = 0; rep_ < REP_FFN; ++rep_) pg8::gemm_phase<pg8::EpiSwiglu, pg8::StaticOrder, true>(lds, g, S, E, tid);
            }
            END_PH();
            if (IN_PH()) { PH_LOCALS
                pg8::Gemm g{(const bf16*)(ws + B_ACT0), (const bf16*)(ws + W_F2), DFF, DFF, DFF}; pg8::StaticOrder S; S.init(M, 1024, G, bx);
                bf16* XR = (bf16*)(ws + WS_XR); pg8::EpiResid<false> E{nullptr, XR, XR, (mod + (size_t)L * 2 * 6144) + 5 * 1024, 6144};
                pg8::gemm_phase<pg8::EpiResid<false>, pg8::StaticOrder, true>(lds, g, S, E, tid);
            }
            END_PH();
        } else {
            LAS int* toff = (LAS int*)(lds + MISC_OFF + 64);
            if (IN_PH()) { PH_LOCALS
                if (tid == 0) { int o = 0; for (int e = 0; e < 8; ++e) { toff[e] = o; o += ((int)__hip_atomic_load((unsigned*)(ctl + CW_ECNT + 64 * e), RLX_AGENT) + 255) >> 8; } toff[8] = o; }
                __syncthreads();
                LAS int* sbase = (LAS int*)(lds + MISC_OFF + 256);
                if (tid < 8) sbase[tid] = toff[tid] * 256 + ((const int*)(ws + WS_BBASE))[vcu * 8 + tid];
                __syncthreads();
                v4u tn0, tn1; v4u an, cn;
                { const GAS v4u* tp = (const GAS v4u*)((const int*)(ws + WS_TOKINFO) + (size_t)gw * 8); tn0 = tp[0]; tn1 = tp[1];
                  const GAS v4u* srcp = (const GAS v4u*)(Hb + (size_t)gw * D) + lane; an = srcp[0]; cn = srcp[64]; }
#pragma unroll 1
                for (int m = gw; m < M; m += NGW) {
                    const v4u t0 = tn0, t1 = tn1; const v4u a = an, c = cn;
                    { const int mn = (m + NGW < M) ? m + NGW : m; const GAS v4u* tp = (const GAS v4u*)((const int*)(ws + WS_TOKINFO) + (size_t)mn * 8); tn0 = tp[0]; tn1 = tp[1];
                      const GAS v4u* srcp = (const GAS v4u*)(Hb + (size_t)mn * D) + lane; an = srcp[0]; cn = srcp[64]; }
                    const int s0 = sbase[t0.x] + (int)t0.y, s1 = sbase[t0.z] + (int)t0.w;
                    GAS v4u* d0 = (GAS v4u*)(HG + (size_t)s0 * D) + lane; GAS v4u* d1 = (GAS v4u*)(HG + (size_t)s1 * D) + lane;
                    d0[0] = a; d0[64] = c; d1[0] = a; d1[64] = c;
                    if (lane == 0) { SW[s0] = __uint_as_float(t1.x); SW[s1] = __uint_as_float(t1.y); }
                }
            }
            END_PH();
            if (IN_PH()) { PH_LOCALS
                if (tid == 0) { int o = 0; for (int e = 0; e < 8; ++e) { toff[e] = o; o += ((int)__hip_atomic_load((unsigned*)(ctl + CW_ECNT + 64 * e), RLX_AGENT) + 255) >> 8; } toff[8] = o; }
                __syncthreads();
                pg8::Gemm g{HG, (const bf16*)(ws + B_MW13), 1024, 1024, 1024}; pg8::MoeOrder S{G, vcu, 28, toff[8], toff};
                pg8::EpiSwiglu E{(bf16*)(ws + B_ACT), DFE, 28};
                _Pragma("unroll 1") for (int rep_ = 0; rep_ < REP_FFN; ++rep_) pg8::gemm_phase<pg8::EpiSwiglu, pg8::MoeOrder, true>(lds, g, S, E, tid);
            }
            END_PH();
            if (IN_PH()) { PH_LOCALS
                if (tid == 0) { int o = 0; for (int e = 0; e < 8; ++e) { toff[e] = o; o += ((int)__hip_atomic_load((unsigned*)(ctl + CW_ECNT + 64 * e), RLX_AGENT) + 255) >> 8; } toff[8] = o; }
                __syncthreads();
                const int nt_ = toff[8], rt0_ = (G % 4 == 0) ? (nt_ / (G / 4)) * (G / 4) : 0, ntail_ = nt_ - rt0_;
                const int F_ = (ntail_ * 28 <= G) ? 7 : (ntail_ * 16 <= G) ? 4 : 2;
                if (rt0_ > 0) { pg8::Gemm g{(const bf16*)(ws + B_ACT), (const bf16*)(ws + B_MW2), DFE, DFE, DFE}; pg8::MoeDownFull S{G, vcu, rt0_, toff};
                  pg8::EpiY E{HG, (bf16*)(ws + B_MW13), SW};
                  pg8::gemm_phase<pg8::EpiY, pg8::MoeDownFull, true>(lds, g, S, E, tid); }
                if (ntail_ > 0) {
                  pg8::Gemm g{(const bf16*)(ws + B_ACT), (const bf16*)(ws + B_MW2), DFE, DFE, DFE / F_}; pg8::MoeTailOrder S{G, vcu, rt0_, ntail_, F_, (2 * DFE) / F_, toff};
                  pg8::EpiYT E{HG, (bf16*)(ws + B_MW13), (bf16*)(ws + B_YT), SW, (2 * DFE) / F_, rt0_ * 256, ntail_ * 256};
                  pg8::gemm_phase<pg8::EpiYT, pg8::MoeTailOrder, true>(lds, g, S, E, tid); }
            }
            END_PH();
            if (IN_PH()) { PH_LOCALS
                if (tid == 0) { int o = 0; for (int e = 0; e < 8; ++e) { toff[e] = o; o += ((int)__hip_atomic_load((unsigned*)(ctl + CW_ECNT + 64 * e), RLX_AGENT) + 255) >> 8; } toff[8] = o; }
                __syncthreads();
                const float* fn = PIN(I_FNORM);
                LAS int* sbase = (LAS int*)(lds + MISC_OFF + 256);
                if (tid < 8) sbase[tid] = toff[tid] * 256 + ((const int*)(ws + WS_BBASE))[vcu * 8 + tid];
                __syncthreads();
                const bf16* Y1 = (const bf16*)(ws + B_MW13); const bf16* YT = (const bf16*)(ws + B_YT);
                const int nt_ = toff[8], rt0_ = (G % 4 == 0) ? (nt_ / (G / 4)) * (G / 4) : 0, ntail_ = nt_ - rt0_;
                const int nx_ = (ntail_ == 0) ? 0 : (ntail_ * 28 <= G) ? 6 : (ntail_ * 16 <= G) ? 3 : 1;
                const int tail0_ = rt0_ * 256, trows_ = ntail_ * 256;
                int cs0, cs1;
                v4u tnn;
                v2u ya[4], yb[4], xw[4];
                { const v4u t0 = *(const GAS v4u*)((const int*)(ws + WS_TOKINFO) + (size_t)gw * 8);
                  const int mn = (gw + NGW < M) ? gw + NGW : gw; tnn = *(const GAS v4u*)((const int*)(ws + WS_TOKINFO) + (size_t)mn * 8);
                  const int s0 = sbase[t0.x] + (int)t0.y, s1 = sbase[t0.z] + (int)t0.w; cs0 = s0; cs1 = s1;
#pragma unroll
                  for (int q = 0; q < 4; ++q) { ya[q] = ((const GAS v2u*)(HG + (size_t)s0 * D) + lane)[64 * q]; yb[q] = ((const GAS v2u*)(HG + (size_t)s1 * D) + lane)[64 * q];
                      xw[q] = ((const GAS v2u*)((const bf16*)(ws + WS_XR) + (size_t)gw * D) + lane)[64 * q]; } }
                f32x4 F4[4];
#pragma unroll
                for (int q = 0; q < 4; ++q) F4[q] = *(const f32x4*)(fn + 256 * q + 4 * lane);
                int m = gw;
#pragma unroll 1
                for (int b = 0; b < M / T; ++b) {
                  f32x4 G4[4];
                  { const float* g2 = (mod + (size_t)L * 2 * 6144) + b * 6144 + 5 * 1024;
#pragma unroll
                    for (int q = 0; q < 4; ++q) G4[q] = *(const f32x4*)(g2 + 256 * q + 4 * lane); }
#pragma unroll 1
                  for (; m < (b + 1) * T; m += NGW) {
                    GAS f32x4* xr = (GAS f32x4*)(outp + (size_t)m * D) + lane;
                    f32x4 v[4]; float ss = 0.f;
                    f32x4 ex[4];
#pragma unroll
                    for (int q = 0; q < 4; ++q) ex[q] = (f32x4){0.f, 0.f, 0.f, 0.f};
                    { const int c0_ = __builtin_amdgcn_readfirstlane(cs0), c1_ = __builtin_amdgcn_readfirstlane(cs1);
                      if (nx_ > 0 && (c0_ >= tail0_ || c1_ >= tail0_)) {
#pragma unroll 1
                        for (int k = 0; k < 2; ++k) { const int cs = k ? c1_ : c0_; if (cs < tail0_) continue;
#pragma unroll 1
                            for (int sx = 0; sx < nx_; ++sx) { const bf16* yr = (sx == 0) ? Y1 + (size_t)cs * D : YT + ((size_t)(sx - 1) * trows_ + (cs - tail0_)) * D;
#pragma unroll
                                for (int q = 0; q < 4; ++q) { const v2u e2 = ((const GAS v2u*)yr + lane)[64 * q]; ex[q] += (f32x4){blo(e2.x), bhi(e2.x), blo(e2.y), bhi(e2.y)}; } } } } }
#pragma unroll
                    for (int q = 0; q < 4; ++q) { const f32x4 g4 = G4[q]; const v2u a = ya[q], d = yb[q];
                        const f32x4 f = ex[q] + (f32x4){blo(a.x) + blo(d.x), bhi(a.x) + bhi(d.x), blo(a.y) + blo(d.y), bhi(a.y) + bhi(d.y)};
                        const v2u x2 = xw[q]; v[q] = (f32x4){blo(x2.x), bhi(x2.x), blo(x2.y), bhi(x2.y)} + g4 * f; ss += (v[q].x * v[q].x + v[q].y * v[q].y) + (v[q].z * v[q].z + v[q].w * v[q].w); }
                    { const int mn = (m + NGW < M) ? m + NGW : m; const v4u t0 = tnn;
                      const int mnn = (mn + NGW < M) ? mn + NGW : mn; tnn = *(const GAS v4u*)((const int*)(ws + WS_TOKINFO) + (size_t)mnn * 8);
                      const int s0 = sbase[t0.x] + (int)t0.y, s1 = sbase[t0.z] + (int)t0.w; cs0 = s0; cs1 = s1;
#pragma unroll
                      for (int q = 0; q < 4; ++q) { ya[q] = ((const GAS v2u*)(HG + (size_t)s0 * D) + lane)[64 * q]; yb[q] = ((const GAS v2u*)(HG + (size_t)s1 * D) + lane)[64 * q];
                          xw[q] = ((const GAS v2u*)((const bf16*)(ws + WS_XR) + (size_t)mn * D) + lane)[64 * q]; } }
                    const float rstd = 1.0f / sqrtf(wave_sum(ss) * (1.f / D) + NORM_EPS);
#pragma unroll
                    for (int q = 0; q < 4; ++q) xr[64 * q] = v[q] * rstd * F4[q];
                  }
                }
            }
            END_PH();
        }
    }
#undef IN_PH
#undef END_PH
}

constexpr int N_PHASES = 1 + 11 + 13;
extern "C" void kernel_launch(void* const* d_in, const int* in_sizes, int n_in, void* d_out, int out_size, void* d_ws, size_t ws_size, hipStream_t stream) {
    static int grid = 0;
    if (grid == 0) {
        if (n_in != 26 || in_sizes[0] != M * D || out_size != M * D || ws_size < WS_NEED) {
            fprintf(stderr, "kernel_launch: unexpected shapes (n_in %d, in0 %d, out %d, ws %zu, need %zu); nothing launched\n", n_in, n_in > 0 ? in_sizes[0] : -1, out_size, ws_size, (size_t)WS_NEED); grid = -1; return; }
        int dev = 0, cus = 0, per_cu = 0;
        if (hipGetDevice(&dev) != hipSuccess || hipDeviceGetAttribute(&cus, hipDeviceAttributeMultiprocessorCount, dev) != hipSuccess) { grid = -1; return; }
        if (hipFuncSetAttribute((const void*)mk_fwd, hipFuncAttributeMaxDynamicSharedMemorySize, LDS_BYTES) != hipSuccess) { fprintf(stderr, "kernel_launch: hipFuncSetAttribute failed\n"); grid = -1; return; }
        if (hipOccupancyMaxActiveBlocksPerMultiprocessor(&per_cu, (const void*)mk_fwd, NWAVES * 64, LDS_BYTES) != hipSuccess || per_cu < 1)
            fprintf(stderr, "kernel_launch: note: occupancy query reports %d workgroups per CU\n", per_cu);
        (void)hipGetLastError();
        grid = cus;
    }
    if (grid < 0) return;
    if (hipMemsetAsync((char*)d_ws + WS_CTL, 0, CTL_ZERO_BYTES, stream) != hipSuccess) return;
    Ptrs p{};
    for (int i = 0; i < 26; ++i) p.in[i] = (const float*)d_in[i];
    p.out = (float*)d_out; p.ws = (unsigned char*)d_ws;
#if MK_MULTI
    for (int k = 0; k < N_PHASES; ++k) { p.ph_lo = k; p.ph_hi = k + 1; hipLaunchKernelGGL(mk_fwd, dim3(grid), dim3(NWAVES * 64), LDS_BYTES, stream, p); }
#else
    p.ph_lo = 0; p.ph_hi = N_PHASES;
    hipLaunchKernelGGL(mk_fwd, dim3(grid), dim3(NWAVES * 64), LDS_BYTES, stream, p);
#endif
}
```
